# Optimizing an MI355X kernel written in HIP

```python
import jax, jax.numpy as jnp
from jax import lax
import numpy as np

D_MODEL = 4096
BATCH = 2
SEQ = 8192
DEPTH = 1
DEC_BATCH = 4
DEC_SEQ = 2048
PAST_LEN = 128

D_MIX = D_MODEL
D_A = D_MIX // 2
HEAD_DIM_A = 128
N_HEADS_A = D_A // HEAD_DIM_A
CHUNK = 128
D_B = D_MIX - D_A
POOL_WINDOWS = (2, 4, 8, 16)
N_POOL_GROUPS = len(POOL_WINDOWS)
D_POOL_GROUP = D_B // N_POOL_GROUPS
D_IN = 2 * D_A + D_B
D_FF = ((8 * D_MODEL // 3 + 255) // 256) * 256
EPS = 1e-6
FFN_RESIDUAL = 0.5

kernel_name = "hybrid_gmlp_pool_encoder"


def rmsnorm(x, g):
    xf = x.astype(jnp.float32)
    ms = jnp.mean(xf * xf, axis=-1, keepdims=True)
    return (xf * lax.rsqrt(ms + EPS) * g.astype(jnp.float32)).astype(x.dtype)


def swiglu(x, w_gate, w_up, w_down):
    return (jax.nn.silu(x @ w_gate) * (x @ w_up)) @ w_down


def spatial_gating(z, w_spatial, b_spatial, v_norm):
    b, s, _ = z.shape
    z = jax.nn.gelu(z, approximate=False)
    u, v = jnp.split(z, 2, axis=-1)
    v = rmsnorm(v.reshape(b, s, N_HEADS_A, HEAD_DIM_A), v_norm)
    v = v.reshape(b, s // CHUNK, CHUNK, N_HEADS_A, HEAD_DIM_A)
    sv = jnp.einsum('hts,bcshd->bcthd', w_spatial, v) + b_spatial.T[None, None, :, :, None]
    return u * sv.reshape(b, s, D_A)


def multiscale_pool(p, w_pool, pool_scale):
    b, s, _ = p.shape
    pf = p.astype(jnp.float32)
    cs = jnp.concatenate([jnp.zeros((b, 1, D_B), jnp.float32), jnp.cumsum(pf, axis=1)], axis=1)
    t = jnp.arange(s)
    outs = []
    for g, w in enumerate(POOL_WINDOWS):
        sl = slice(g * D_POOL_GROUP, (g + 1) * D_POOL_GROUP)
        lo = jnp.maximum(t - w // 2, 0)
        hi = jnp.minimum(t + w // 2, s)
        csg = cs[..., sl]
        win_sum = jnp.take(csg, hi, axis=1) - jnp.take(csg, lo, axis=1)
        count = (hi - lo).astype(jnp.float32)[None, :, None]
        outs.append((win_sum / count - pf[..., sl]).astype(p.dtype))
    pooled = jnp.stack(outs, axis=2)
    y = jnp.einsum('bsgi,gio->bsgo', pooled, w_pool)
    return y.reshape(b, s, D_B) * pool_scale


def run_trunk(x, ffn1_pre, ffn1_post, ffn1_gate, ffn1_up, ffn1_down,
              mix_pre, mix_post, w_in, w_spatial, b_spatial, v_norm, w_pool, pool_scale, w_out,
              ffn2_pre, ffn2_post, ffn2_gate, ffn2_up, ffn2_down, final_norm):
    h = x
    for l in range(DEPTH):
        h = h + FFN_RESIDUAL * rmsnorm(
            swiglu(rmsnorm(h, ffn1_pre[l]), ffn1_gate[l], ffn1_up[l], ffn1_down[l]), ffn1_post[l])
        a = rmsnorm(h, mix_pre[l])
        z = a @ w_in[l]
        y_a = spatial_gating(z[..., :2 * D_A], w_spatial[l], b_spatial[l], v_norm[l])
        y_b = multiscale_pool(z[..., 2 * D_A:], w_pool[l], pool_scale[l])
        y = jnp.concatenate([y_a, y_b], axis=-1) @ w_out[l]
        h = h + rmsnorm(y, mix_post[l])
        h = h + FFN_RESIDUAL * rmsnorm(
            swiglu(rmsnorm(h, ffn2_pre[l]), ffn2_gate[l], ffn2_up[l], ffn2_down[l]), ffn2_post[l])
        h = rmsnorm(h, final_norm[l])
    return h


def setup_inputs(seed: int = 0) -> dict:
    key = jax.random.key(seed)
    ks = jax.random.split(key, 24)
    f32 = jnp.float32

    def nrm(k, shape, scale):
        return jax.random.normal(k, shape, f32) * scale

    def gain(k, shape):
        return jnp.ones(shape, f32) + 0.1 * jax.random.normal(k, shape, f32)

    L = DEPTH
    return {
        "x_prompt": jax.random.normal(ks[0], (BATCH, SEQ, D_MODEL), f32),
        "x_sample": jax.random.normal(ks[1], (DEC_BATCH, DEC_SEQ, D_MODEL), f32),
        "ffn1_pre": gain(ks[2], (L, D_MODEL)),
        "ffn1_post": gain(ks[3], (L, D_MODEL)),
        "ffn1_gate": nrm(ks[4], (L, D_MODEL, D_FF), D_MODEL ** -0.5),
        "ffn1_up": nrm(ks[5], (L, D_MODEL, D_FF), D_MODEL ** -0.5),
        "ffn1_down": nrm(ks[6], (L, D_FF, D_MODEL), D_FF ** -0.5),
        "mix_pre": gain(ks[7], (L, D_MODEL)),
        "mix_post": gain(ks[8], (L, D_MODEL)),
        "w_in": nrm(ks[9], (L, D_MODEL, D_IN), D_MODEL ** -0.5),
        "w_spatial": nrm(ks[10], (L, N_HEADS_A, CHUNK, CHUNK), CHUNK ** -0.5),
        "b_spatial": gain(ks[11], (L, N_HEADS_A, CHUNK)),
        "v_norm": gain(ks[12], (L, N_HEADS_A, HEAD_DIM_A)),
        "w_pool": nrm(ks[13], (L, N_POOL_GROUPS, D_POOL_GROUP, D_POOL_GROUP), D_POOL_GROUP ** -0.5),
        "pool_scale": gain(ks[14], (L, D_B)),
        "w_out": nrm(ks[15], (L, D_MIX, D_MODEL), D_MIX ** -0.5),
        "ffn2_pre": gain(ks[16], (L, D_MODEL)),
        "ffn2_post": gain(ks[17], (L, D_MODEL)),
        "ffn2_gate": nrm(ks[18], (L, D_MODEL, D_FF), D_MODEL ** -0.5),
        "ffn2_up": nrm(ks[19], (L, D_MODEL, D_FF), D_MODEL ** -0.5),
        "ffn2_down": nrm(ks[20], (L, D_FF, D_MODEL), D_FF ** -0.5),
        "final_norm": gain(ks[21], (L, D_MODEL)),
    }


def reference(x_prompt, x_sample, ffn1_pre, ffn1_post, ffn1_gate, ffn1_up, ffn1_down,
              mix_pre, mix_post, w_in, w_spatial, b_spatial, v_norm, w_pool, pool_scale, w_out,
              ffn2_pre, ffn2_post, ffn2_gate, ffn2_up, ffn2_down, final_norm):
    y_prompt = run_trunk(x_prompt, ffn1_pre, ffn1_post, ffn1_gate, ffn1_up, ffn1_down,
                         mix_pre, mix_post, w_in, w_spatial, b_spatial, v_norm, w_pool, pool_scale, w_out,
                         ffn2_pre, ffn2_post, ffn2_gate, ffn2_up, ffn2_down, final_norm)
    y_sample = run_trunk(x_sample, ffn1_pre, ffn1_post, ffn1_gate, ffn1_up, ffn1_down,
                         mix_pre, mix_post, w_in, w_spatial, b_spatial, v_norm, w_pool, pool_scale, w_out,
                         ffn2_pre, ffn2_post, ffn2_gate, ffn2_up, ffn2_down, final_norm)
    return (y_prompt, y_sample)
```

```cpp
#include <hip/hip_runtime.h>
#include <cstdio>
#include <cstdint>

namespace pg8 {
#define PG8_LAS __attribute__((address_space(3)))
typedef unsigned short bf16_t;
typedef short bf16x8 __attribute__((ext_vector_type(8)));
typedef float f32x4 __attribute__((ext_vector_type(4)));
typedef float f32x2 __attribute__((ext_vector_type(2)));
typedef unsigned u32x4 __attribute__((ext_vector_type(4)));
typedef unsigned u32x2 __attribute__((ext_vector_type(2)));
constexpr int BM = 256, BK = 64, HALF = 128, HTB = HALF * BK * 2  , STAGE_BYTES = 8 * HTB, NXCD = 8, WGM = 8;

__host__ __device__ __forceinline__ int lds_byte(int r, int c) { const int st = (r >> 4) * 2 + (c >> 5), rr = r & 15, cc = c & 31, ob = rr * 64 + cc * 2; return st * 1024 + (ob ^ (((ob >> 9) & 1) << 5)); }
__host__ __device__ __forceinline__ void stage_rc(int b, int& R, int& C) { const int st = b / 1024, sb = b % 1024, swz = sb ^ (((sb >> 9) & 1) << 5); R = (st >> 1) * 16 + swz / 64; C = (st & 1) * 32 + (swz % 64) / 2; }
__host__ __device__ __forceinline__ int perm32(int rho) { const int n = rho >> 4, i = rho & 15; return 8 * (i >> 2) + 4 * n + (i & 3); }

struct Unit { int pm, pn; };
struct Gemm { const bf16_t* A; const bf16_t* Bt; int lda, ldb, K, a_cmul; };

struct StaticOrder {
    int nM, nN, nwg, G, c;
    __host__ __device__ void init(int M, int N, int G_, int c_) { nM = M / BM; nN = N / BM; nwg = nM * nN; G = G_; c = c_; }
    __host__ __device__ bool next(int i, Unit& u) const {
        const long L = (long)i * G + c; if (L >= nwg) return false;
        int wgid = (int)L; { const int q = nwg / NXCD, r = nwg % NXCD, xcd = wgid % NXCD, off = wgid / NXCD; wgid = (xcd < r ? xcd * (q + 1) : r * (q + 1) + (xcd - r) * q) + off; }
        const int nig = WGM * nN, gid = wgid / nig, fm = gid * WGM, gsz = (nM - fm) < WGM ? (nM - fm) : WGM;
        u.pm = fm + ((wgid % nig) % gsz); u.pn = (wgid % nig) / gsz; return true;
    }
    __device__ __forceinline__ void a_ready(const Unit&) const {}
    __device__ __forceinline__ void done(const Unit&) const {}
};

__device__ __forceinline__ unsigned cvt_pk_bf16(float lo, float hi) { unsigned r; asm volatile("v_cvt_pk_bf16_f32 %0, %1, %2" : "=v"(r) : "v"(lo), "v"(hi)); return r; }
__device__ __forceinline__ f32x2 gelu_pk(f32x2 v) {
    const f32x2 av = __builtin_elementwise_abs(v), d = av * 0.2316418882f + 1.0f;
    f32x2 t; t.x = __builtin_amdgcn_rcpf(d.x); t.y = __builtin_amdgcn_rcpf(d.y);
    f32x2 q = t * 0.5307027145f + (-0.7265760135f); q = q * t + 0.7107068705f; q = q * t + (-0.142248368f); q = q * t + 0.127414796f; q = q * t;
    const f32x2 s = (v * v) * (-0.72134752044f);
    f32x2 e; e.x = __builtin_amdgcn_exp2f(s.x); e.y = __builtin_amdgcn_exp2f(s.y);
    const f32x2 m = v * (q * e), r = v - m;
    f32x2 o; o.x = v.x < 0.f ? m.x : r.x; o.y = v.y < 0.f ? m.y : r.y; return o;
}
__device__ __forceinline__ float silu_f(float g) { return g * __builtin_amdgcn_rcpf(1.0f + __builtin_amdgcn_exp2f(-1.44269504f * g)); }

struct EpiSwiGLU {
    static constexpr bool PERM = true, AFTER_DRAIN = false;
    bf16_t* O; int ldc;
    __device__ __forceinline__ void operator()(const f32x4 (&acc)[2][2][4][2], const Unit& u, int wr, int wc, int fr, int fq) const {
        const int row0 = u.pm * BM + wr * 64 + fr, col0 = u.pn * HALF + wc * 32 + 8 * fq;
#pragma unroll
        for (int ai = 0; ai < 2; ++ai)
#pragma unroll
            for (int m = 0; m < 4; ++m) { bf16_t* rowp = O + (size_t)(row0 + ai * HALF + m * 16) * ldc + col0;
                const f32x4 g0 = acc[ai][0][m][0], g1 = acc[ai][0][m][1], u0 = acc[ai][1][m][0], u1 = acc[ai][1][m][1];
                u32x4 w;
                w.x = cvt_pk_bf16(silu_f(g0[0]) * u0[0], silu_f(g0[1]) * u0[1]); w.y = cvt_pk_bf16(silu_f(g0[2]) * u0[2], silu_f(g0[3]) * u0[3]);
                w.z = cvt_pk_bf16(silu_f(g1[0]) * u1[0], silu_f(g1[1]) * u1[1]); w.w = cvt_pk_bf16(silu_f(g1[2]) * u1[2], silu_f(g1[3]) * u1[3]);
                *(u32x4*)rowp = w; }
    }
};
struct EpiYStats {
    static constexpr bool PERM = true, AFTER_DRAIN = false;
    bf16_t* O; int ldc; float* stats;
    __device__ __forceinline__ void operator()(const f32x4 (&acc)[2][2][4][2], const Unit& u, int wr, int wc, int fr, int fq) const {
        const int row0 = u.pm * BM + wr * 64 + fr, col0 = u.pn * BM + wc * 32 + 8 * fq;
#pragma unroll
        for (int ai = 0; ai < 2; ++ai)
#pragma unroll
            for (int m = 0; m < 4; ++m) { const int row = row0 + ai * HALF + m * 16; bf16_t* rowp = O + (size_t)row * ldc + col0; float ss = 0.f;
#pragma unroll
                for (int bj = 0; bj < 2; ++bj) { const f32x4 v0 = acc[ai][bj][m][0], v1 = acc[ai][bj][m][1];
                    ss += (v0[0] * v0[0] + v0[1] * v0[1]) + (v0[2] * v0[2] + v0[3] * v0[3]) + (v1[0] * v1[0] + v1[1] * v1[1]) + (v1[2] * v1[2] + v1[3] * v1[3]);
                    u32x4 w; w.x = cvt_pk_bf16(v0[0], v0[1]); w.y = cvt_pk_bf16(v0[2], v0[3]); w.z = cvt_pk_bf16(v1[0], v1[1]); w.w = cvt_pk_bf16(v1[2], v1[3]);
                    *(u32x4*)(rowp + bj * HALF) = w; }
                ss += __shfl_xor(ss, 16); ss += __shfl_xor(ss, 32);
                if (fq == 0) stats[(size_t)row * 64 + u.pn * 4 + wc] = ss; }
    }
};
struct EpiZ {
    static constexpr bool PERM = true, AFTER_DRAIN = false;
    bf16_t* O; int ldc; int gelu_tiles;
    __device__ __forceinline__ void operator()(const f32x4 (&acc)[2][2][4][2], const Unit& u, int wr, int wc, int fr, int fq) const {
        const int row0 = u.pm * BM + wr * 64 + fr, col0 = u.pn * BM + wc * 32 + 8 * fq; const bool act = u.pn < gelu_tiles;
#pragma unroll
        for (int ai = 0; ai < 2; ++ai)
#pragma unroll
            for (int m = 0; m < 4; ++m) { bf16_t* rowp = O + (size_t)(row0 + ai * HALF + m * 16) * ldc + col0;
#pragma unroll
                for (int bj = 0; bj < 2; ++bj) { f32x4 v0 = acc[ai][bj][m][0], v1 = acc[ai][bj][m][1];
                    if (act) { const f32x2 a = gelu_pk((f32x2){v0[0], v0[1]}), b = gelu_pk((f32x2){v0[2], v0[3]}), c = gelu_pk((f32x2){v1[0], v1[1]}), d = gelu_pk((f32x2){v1[2], v1[3]});
                        v0 = (f32x4){a.x, a.y, b.x, b.y}; v1 = (f32x4){c.x, c.y, d.x, d.y}; }
                    u32x4 w; w.x = cvt_pk_bf16(v0[0], v0[1]); w.y = cvt_pk_bf16(v0[2], v0[3]); w.z = cvt_pk_bf16(v1[0], v1[1]); w.w = cvt_pk_bf16(v1[2], v1[3]);
                    *(u32x4*)(rowp + bj * HALF) = w; } }
    }
};
struct EpiScale {
    static constexpr bool PERM = true, AFTER_DRAIN = false;
    bf16_t* O; int ldc; int ocol; const float* scale;
    __device__ __forceinline__ void operator()(const f32x4 (&acc)[2][2][4][2], const Unit& u, int wr, int wc, int fr, int fq) const {
        const int row0 = u.pm * BM + wr * 64 + fr, col0 = u.pn * BM + wc * 32 + 8 * fq;
        f32x4 sv[2][2];
#pragma unroll
        for (int bj = 0; bj < 2; ++bj)
#pragma unroll
            for (int n = 0; n < 2; ++n) sv[bj][n] = *(const f32x4*)(scale + col0 + bj * HALF + 4 * n);
#pragma unroll
        for (int ai = 0; ai < 2; ++ai)
#pragma unroll
            for (int m = 0; m < 4; ++m) { bf16_t* rowp = O + (size_t)(row0 + ai * HALF + m * 16) * ldc + ocol + col0;
#pragma unroll
                for (int bj = 0; bj < 2; ++bj) { const f32x4 v0 = acc[ai][bj][m][0] * sv[bj][0], v1 = acc[ai][bj][m][1] * sv[bj][1];
                    u32x4 w; w.x = cvt_pk_bf16(v0[0], v0[1]); w.y = cvt_pk_bf16(v0[2], v0[3]); w.z = cvt_pk_bf16(v1[0], v1[1]); w.w = cvt_pk_bf16(v1[2], v1[3]);
                    *(u32x4*)(rowp + bj * HALF) = w; } }
    }
};

template <class Epi, class Sched, bool ALIGN_EPI>
__device__ __forceinline__ void gemm_phase(PG8_LAS unsigned char* lds, const Gemm g, const Sched& S, const Epi& E) {
    const int tid = threadIdx.x, wid = __builtin_amdgcn_readfirstlane(tid >> 6), lane = tid & 63, wr = wid >> 2, wc = wid & 3, fr = lane & 15, fq = lane >> 4;
    const int K = g.K, nt = K / BK;
    unsigned voffA[2], voffB[2];
#pragma unroll
    for (int i = 0; i < 2; ++i) { int R, C; stage_rc(tid * 16 + i * 8192, R, C); const int Rb = Epi::PERM ? ((R & ~31) + perm32(R & 31)) : R;
        voffA[i] = (unsigned)(R * g.lda + C) * 2u; voffB[i] = (unsigned)(Rb * g.ldb + C) * 2u; }
    const size_t kstep = (size_t)(BK * 2);
    const size_t hstepA = (size_t)HALF * g.lda * 2, hstepB = (size_t)HALF * g.ldb * 2;
    const size_t tstepA = 2 * hstepA, tstepB = 2 * hstepB;
    const size_t acstep = (size_t)g.a_cmul * 2;
    const unsigned ldsw = (unsigned)wid * 1024u;
    const int aoff = lds_byte(wr * 64 + fr, fq * 8), boff = lds_byte(wc * 32 + fr, fq * 8);
#define PG8_SA(b, h) (((b) * 2 + (h)) * HTB)
#define PG8_SB(b, h) ((4 + (b) * 2 + (h)) * HTB)
#define PG8_STAGE(bufoff, gbase, voff) do { _Pragma("unroll") for (int _i = 0; _i < 2; ++_i) \
        __builtin_amdgcn_global_load_lds((const unsigned*)((const char*)(gbase) + (voff)[_i]), (PG8_LAS unsigned*)(lds + (bufoff) + ldsw + _i * 8192), 16, 0, 0); } while (0)
#define PG8_LDA(dst, b, h) do { _Pragma("unroll") for (int m = 0; m < 4; ++m) _Pragma("unroll") for (int k = 0; k < 2; ++k) dst[m][k] = *(const PG8_LAS bf16x8*)(lds + PG8_SA(b, h) + aoff + m * 2048 + k * 1024); } while (0)
#define PG8_LDB(dst, b, h) do { _Pragma("unroll") for (int n = 0; n < 2; ++n) _Pragma("unroll") for (int k = 0; k < 2; ++k) dst[n][k] = *(const PG8_LAS bf16x8*)(lds + PG8_SB(b, h) + boff + n * 2048 + k * 1024); } while (0)
#define PG8_MMA(ai, bj, At, Bt) do { __builtin_amdgcn_s_setprio(1); _Pragma("unroll") for (int m = 0; m < 4; ++m) _Pragma("unroll") for (int n = 0; n < 2; ++n) _Pragma("unroll") for (int k = 0; k < 2; ++k) \
        acc[ai][bj][m][n] = __builtin_amdgcn_mfma_f32_16x16x32_bf16(Bt[n][k], At[m][k], acc[ai][bj][m][n], 0, 0, 0); __builtin_amdgcn_s_setprio(0); } while (0)
#define PG8_WAIT_V(n) asm volatile("s_waitcnt vmcnt(" #n ")" ::: "memory")
#define PG8_WAIT_L(n) asm volatile("s_waitcnt lgkmcnt(" #n ")" ::: "memory")
#define PG8_BAR __builtin_amdgcn_s_barrier()
#define PG8_SCHED __builtin_amdgcn_sched_barrier(0)
#define PG8_UA(u) ((const char*)g.A + (size_t)(u).pm * tstepA + (size_t)((u).pn >> 1) * acstep)
#define PG8_UB(u) ((const char*)g.Bt + (size_t)(u).pn * tstepB)
    Unit cur, nxt; int ui = 0;
    if (!S.next(0, cur)) return;
    f32x4 acc[2][2][4][2];
#pragma unroll
    for (int a = 0; a < 2; ++a)
#pragma unroll
        for (int b = 0; b < 2; ++b)
#pragma unroll
            for (int m = 0; m < 4; ++m)
#pragma unroll
                for (int n = 0; n < 2; ++n) acc[a][b][m][n] = (f32x4){0.f, 0.f, 0.f, 0.f};
    bf16x8 At[4][2], B0[2][2], B1[2][2];
    const char* cA = PG8_UA(cur); const char* cB = PG8_UB(cur);
    S.a_ready(cur);
    PG8_STAGE(PG8_SB(0, 0), cB, voffB); PG8_STAGE(PG8_SB(0, 1), cB + hstepB, voffB); PG8_STAGE(PG8_SA(0, 0), cA, voffA); PG8_STAGE(PG8_SA(0, 1), cA + hstepA, voffA);
    if (wr == 1) PG8_BAR;
    PG8_WAIT_V(2); PG8_BAR;
    PG8_STAGE(PG8_SB(1, 0), cB + kstep, voffB); PG8_STAGE(PG8_SA(1, 0), cA + kstep, voffA); PG8_STAGE(PG8_SB(1, 1), cB + hstepB + kstep, voffB);
    PG8_WAIT_V(6); PG8_BAR;
    for (;;) {
        const bool has_next = S.next(ui + 1, nxt);
        const char* nA = has_next ? PG8_UA(nxt) : cA; const char* nB = has_next ? PG8_UB(nxt) : cB;
        for (int t = 0; t < nt; t += 2) {
            const bool last = (t == nt - 2);
            const char* a1 = cA + (size_t)(t + 1) * kstep;
            const char* a2 = last ? nA : cA + (size_t)(t + 2) * kstep; const char* b2 = last ? nB : cB + (size_t)(t + 2) * kstep;
            const char* a3 = a2 + kstep; const char* b3 = b2 + kstep;
            if (last && has_next) S.a_ready(nxt);
            PG8_LDB(B0, 0, 0); PG8_LDB(B1, 0, 1); PG8_SCHED; PG8_LDA(At, 0, 0); PG8_STAGE(PG8_SA(1, 1), a1 + hstepA, voffA);
            PG8_WAIT_V(8); PG8_WAIT_L(0); PG8_BAR; PG8_MMA(0, 0, At, B0); PG8_MMA(0, 1, At, B1); PG8_BAR; PG8_SCHED;
            PG8_LDA(At, 0, 1); PG8_STAGE(PG8_SB(0, 0), b2, voffB); PG8_STAGE(PG8_SB(0, 1), b2 + hstepB, voffB); PG8_STAGE(PG8_SA(0, 0), a2, voffA);
            PG8_WAIT_V(8); PG8_WAIT_L(0); PG8_BAR; PG8_MMA(1, 0, At, B0); PG8_MMA(1, 1, At, B1); PG8_BAR; PG8_SCHED;
            PG8_LDB(B0, 1, 0); PG8_LDB(B1, 1, 1); PG8_SCHED; PG8_LDA(At, 1, 0); PG8_STAGE(PG8_SA(0, 1), a2 + hstepA, voffA);
            PG8_WAIT_V(8); PG8_WAIT_L(0); PG8_BAR; PG8_MMA(0, 0, At, B0); PG8_MMA(0, 1, At, B1); PG8_BAR; PG8_SCHED;
            PG8_LDA(At, 1, 1); PG8_STAGE(PG8_SB(1, 0), b3, voffB); PG8_STAGE(PG8_SB(1, 1), b3 + hstepB, voffB); PG8_STAGE(PG8_SA(1, 0), a3, voffA);
            PG8_WAIT_V(8); PG8_WAIT_L(0); PG8_BAR; PG8_MMA(1, 0, At, B0); PG8_MMA(1, 1, At, B1); PG8_BAR; PG8_SCHED;
        }
        if constexpr (ALIGN_EPI) { if (wr == 0) PG8_BAR; }
        E(acc, cur, wr, wc, fr, fq); S.done(cur);
        if (!has_next) break;
#pragma unroll
        for (int a = 0; a < 2; ++a)
#pragma unroll
            for (int b = 0; b < 2; ++b)
#pragma unroll
                for (int m = 0; m < 4; ++m)
#pragma unroll
                    for (int n = 0; n < 2; ++n) acc[a][b][m][n] = (f32x4){0.f, 0.f, 0.f, 0.f};
        cur = nxt; cA = nA; cB = nB; ++ui;
        if constexpr (ALIGN_EPI) { if (wr == 1) PG8_BAR; }
    }
    PG8_WAIT_V(0);
    if constexpr (!ALIGN_EPI) { if (wr == 0) PG8_BAR; }
    PG8_BAR;
#undef PG8_SA
#undef PG8_SB
#undef PG8_STAGE
#undef PG8_LDA
#undef PG8_LDB
#undef PG8_MMA
#undef PG8_WAIT_V
#undef PG8_WAIT_L
#undef PG8_BAR
#undef PG8_SCHED
#undef PG8_UA
#undef PG8_UB
}
}

constexpr int NWAVES = 8;
#ifndef MK_N_LAUNCHES
#define MK_N_LAUNCHES 1
#endif
constexpr int N_PHASES = 12;
constexpr int N_LAUNCHES = MK_N_LAUNCHES;
static_assert(N_LAUNCHES == 1 || N_LAUNCHES == N_PHASES, "MK_N_LAUNCHES is 1 or 12");

constexpr int M = 24576, M_PROMPT = 16384, SEQ_P = 8192, SEQ_S = 2048;
constexpr int D = 4096, FF = 11008, NGU = 2 * FF, DIN = 6144, DA = 2048, DB = 2048, NH = 16, HD = 128, CH = 128, DPG = 512;
constexpr float EPS = 1e-6f;

constexpr size_t MiB = 1u << 20;
constexpr size_t WS_CTL = 0, CTL_ZERO_BYTES = 1 * MiB;
constexpr size_t WS_STATS = 1 * MiB;
constexpr size_t WS_WGU1 = 8 * MiB, WS_WD1 = 180 * MiB, WS_WGU2 = 266 * MiB, WS_WD2 = 438 * MiB;
constexpr size_t WS_WIN = 524 * MiB, WS_WOUT = 572 * MiB, WS_WSP = 604 * MiB, WS_WPT = 605 * MiB;
constexpr size_t WS_A = 608 * MiB;
constexpr size_t WS_HID = 800 * MiB;
constexpr size_t WS_Z = WS_HID, WS_YCAT = WS_HID + 288 * MiB;
constexpr size_t WS_Y = 1316 * MiB;
constexpr size_t WS_END = 1508 * MiB;
static_assert(WS_WGU1 + (size_t)NGU * D * 2 <= WS_WD1 && WS_WD1 + (size_t)D * FF * 2 <= WS_WGU2 && WS_WGU2 + (size_t)NGU * D * 2 <= WS_WD2 && WS_WD2 + (size_t)D * FF * 2 <= WS_WIN, "ws map 1");
static_assert(WS_WIN + (size_t)DIN * D * 2 <= WS_WOUT && WS_WOUT + (size_t)D * D * 2 <= WS_WSP && WS_WSP + (size_t)NH * CH * CH * 2 <= WS_WPT && WS_WPT + (size_t)DB * DPG * 2 <= WS_A, "ws map 2");
static_assert(WS_A + (size_t)M * D * 2 <= WS_HID && WS_HID + (size_t)M * FF * 2 <= WS_Y && WS_Y + (size_t)M * D * 2 <= WS_END && WS_YCAT + (size_t)M * D * 2 <= WS_Y && WS_Z + (size_t)M * DIN * 2 <= WS_YCAT, "ws map 3");
static_assert(WS_STATS + (size_t)M * 64 * 4 <= WS_WGU1, "ws map 4");
constexpr int CW_TMO = 0, CW_CODE = 1;
constexpr int CW_BAR = 4096;

constexpr int RING_OFF = 0, RING_BYTES = 131072;
constexpr int LDSCTL_OFF = RING_BYTES, MISC_OFF = LDSCTL_OFF + 320;
constexpr int LDS_BYTES = 147456;
static_assert(MISC_OFF + 128 <= LDS_BYTES, "LDS map");

#define GAS __attribute__((address_space(1)))
#define LAS __attribute__((address_space(3)))
typedef unsigned short bf16;
typedef unsigned v4u __attribute__((ext_vector_type(4)));
typedef unsigned v2u __attribute__((ext_vector_type(2)));
typedef float f32x4 __attribute__((ext_vector_type(4)));
typedef short bf16x8 __attribute__((ext_vector_type(8)));
typedef GAS unsigned gu32;
#define RLX_AGENT __ATOMIC_RELAXED, __HIP_MEMORY_SCOPE_AGENT
#define LDS_WAIT() asm volatile("s_waitcnt lgkmcnt(0)" ::: "memory")
#define VM_WAIT() asm volatile("s_waitcnt vmcnt(0)" ::: "memory")
__device__ __forceinline__ unsigned f2bf(float f) { unsigned u = __builtin_bit_cast(unsigned, f); return (u + 0x7fffu + ((u >> 16) & 1u)) >> 16; }
__device__ __forceinline__ unsigned pk2(float lo, float hi) { return f2bf(lo) | (f2bf(hi) << 16); }
__device__ __forceinline__ float bf_lo(unsigned w) { return __builtin_bit_cast(float, w << 16); }
__device__ __forceinline__ float bf_hi(unsigned w) { return __builtin_bit_cast(float, w & 0xffff0000u); }

#define XB_TMO      128
#define XB_XCNT(j)  (256  + 64 * (j))
#define XB_XSUB(j)  (1280 + 64 * (j))
#define XB_XGEN(j)  (2304 + 64 * (j))
#define XB_TOP      3328
#define XB_TOPGEN   3392
#define XCD_BAR_WORDS 3456
#define XB_SPIN_CAP (1u << 18)

__device__ __forceinline__ unsigned xb_ld(unsigned* p)              { return __hip_atomic_load(p, __ATOMIC_RELAXED, __HIP_MEMORY_SCOPE_AGENT); }
__device__ __forceinline__ unsigned xb_add(unsigned* p, unsigned v) { return __hip_atomic_fetch_add(p, v, __ATOMIC_RELAXED, __HIP_MEMORY_SCOPE_AGENT); }
__device__ __forceinline__ unsigned xb_xcc_id() { return (unsigned)__builtin_amdgcn_s_getreg((3 << 11) | 20) & 0xFu; }
#define XB_SPIN(cond, bar) do { unsigned _sp = 0; while (cond) { __builtin_amdgcn_s_sleep(1); \
    if ((++_sp & 255u) == 0u) { if (xb_ld(&(bar)[XB_TMO])) break; if (_sp > XB_SPIN_CAP) { atomicAdd(&(bar)[XB_TMO], 1u); break; } } } } while (0)

struct XcdBarrier {
    unsigned* bar; unsigned x;
    volatile LAS unsigned* st;
};

__device__ __forceinline__ XcdBarrier xcd_barrier_post(unsigned* bar, volatile LAS unsigned* st) {
    XcdBarrier b; b.bar = bar; b.x = xb_xcc_id(); b.st = st;
    if (threadIdx.x == 0) (void)xb_add(&bar[XB_XCNT(b.x)], 1u);
    return b;
}
__device__ __forceinline__ void xcd_barrier_complete(unsigned* bar, unsigned x, unsigned& nloc, unsigned& nx) {
    const unsigned G = gridDim.x * gridDim.y * gridDim.z;
    unsigned sum, cnt, mine, sp = 0u;
    for (;;) {
        sum = 0u; cnt = 0u; mine = 0u;
#pragma unroll
        for (unsigned j = 0; j < 16; ++j) { const unsigned c = xb_ld(&bar[XB_XCNT(j)]); sum += c; cnt += (c > 0u) ? 1u : 0u; mine = (j == x) ? c : mine; }
        if (sum == G) break;
        __builtin_amdgcn_s_sleep(1);
        if ((++sp & 255u) == 0u) { if (xb_ld(&bar[XB_TMO])) break; if (sp > XB_SPIN_CAP) { atomicAdd(&bar[XB_TMO], 1u); break; } }
    }
    nloc = mine > 0u ? mine : 1u; nx = cnt > 0u ? cnt : 1u;
}

__device__ __forceinline__ void xcd_barrier(const XcdBarrier& b) {
    asm volatile("s_waitcnt vmcnt(0)" ::: "memory");
    __syncthreads();
    if (threadIdx.x == 0) {
        unsigned* bar = b.bar;
        __builtin_amdgcn_s_waitcnt(0);
        unsigned nloc = b.st[0], nx = b.st[1];
        if (nloc == 0u) { xcd_barrier_complete(bar, b.x, nloc, nx); b.st[0] = nloc; b.st[1] = nx; }
        const unsigned old = xb_add(&bar[XB_XSUB(b.x)], 1u);
        const unsigned gen = old / nloc;
        if (old + 1u == (gen + 1u) * nloc) {
            __builtin_amdgcn_fence(__ATOMIC_RELEASE, "agent");
            asm volatile("s_waitcnt vmcnt(0)" ::: "memory");
            const unsigned og = xb_add(&bar[XB_TOP], 1u);
            const unsigned tg = og / nx;
            if (og + 1u == (tg + 1u) * nx) xb_add(&bar[XB_TOPGEN], 1u);
            else XB_SPIN(xb_ld(&bar[XB_TOPGEN]) == tg, bar);
            __builtin_amdgcn_fence(__ATOMIC_ACQUIRE, "agent");
            xb_add(&bar[XB_XGEN(b.x)], 1u);
            asm volatile("s_waitcnt vmcnt(0)" ::: "memory");
        } else {
            XB_SPIN(xb_ld(&bar[XB_XGEN(b.x)]) == gen, bar);
            __builtin_amdgcn_fence(__ATOMIC_ACQUIRE, "agent");
            asm volatile("s_waitcnt vmcnt(0)" ::: "memory");
        }
    }
    __syncthreads();
}

struct Frame {
    LAS unsigned char* lds;
    volatile LAS unsigned* MISC;
    gu32* ctl;
    int tid, lane, wave;
    int vcu, G;
};

__device__ __forceinline__ float wave_sum(float v) {
#pragma unroll
    for (int o = 1; o < 64; o <<= 1) v += __shfl_xor(v, o);
    return v;
}
__device__ __forceinline__ void p0_transpose_item(const float* W, int K, int N, bf16* WT, int mode, int row_off, LAS float* scr, int item, int lane) {
    const int nblk = N / 32, kb = item / nblk, nb = item % nblk, k0 = 64 * kb, n0 = 32 * nb;
    const int drow0 = (mode == 0) ? row_off + n0 : 256 * (n0 >> 7) + (n0 & 127) + (mode == 2 ? 128 : 0);
#pragma unroll 8
    for (int i = 0; i < 32; ++i) { const int kk = 2 * i + (lane >> 5); scr[kk * 33 + (lane & 31)] = W[(size_t)(k0 + kk) * N + n0 + (lane & 31)]; }
    LDS_WAIT(); asm volatile("" ::: "memory");
    const int c = lane & 7;
#pragma unroll
    for (int j = 0; j < 4; ++j) { const int n = (lane >> 3) + 8 * j; const LAS float* s = scr + (8 * c) * 33 + n;
        v4u o; o.x = pk2(s[0 * 33], s[1 * 33]); o.y = pk2(s[2 * 33], s[3 * 33]); o.z = pk2(s[4 * 33], s[5 * 33]); o.w = pk2(s[6 * 33], s[7 * 33]);
        *(GAS v4u*)(WT + (size_t)(drow0 + n) * K + k0 + 8 * c) = o; }
    LDS_WAIT(); asm volatile("" ::: "memory");
}
__device__ __forceinline__ const float* x_row(const float* xp, const float* xs, int m) { return m < M_PROMPT ? xp + (size_t)m * D : xs + (size_t)(m - M_PROMPT) * D; }

__device__ __forceinline__ void rms_row_to_bf16(int lane, const float* xrow, const float* g, bf16* orow) {
    const GAS f32x4* xr = (const GAS f32x4*)xrow + lane; const GAS f32x4* gr = (const GAS f32x4*)g + lane;
    f32x4 v[16]; float s = 0.f;
#pragma unroll
    for (int j = 0; j < 16; ++j) { v[j] = xr[64 * j]; s += (v[j].x * v[j].x + v[j].y * v[j].y) + (v[j].z * v[j].z + v[j].w * v[j].w); }
    const float r = 1.0f / sqrtf(wave_sum(s) * (1.f / D) + EPS);
    GAS v2u* o8 = (GAS v2u*)orow + lane;
#pragma unroll
    for (int j = 0; j < 16; ++j) { const f32x4 gg = gr[64 * j]; v2u w; w.x = pk2(v[j].x * r * gg.x, v[j].y * r * gg.y); w.y = pk2(v[j].z * r * gg.z, v[j].w * r * gg.w); o8[64 * j] = w; }
}

template <bool FINAL>
__device__ __forceinline__ void norm_phase(Frame& F, const float* baseP, const float* baseS, const bf16* Y, const float* stats, float c, const float* gpost, const float* g2, float* H, bf16* A) {
    LAS f32x4* gl = (LAS f32x4*)(F.lds + RING_OFF);
    for (int i = F.tid; i < D / 4; i += NWAVES * 64) { gl[i] = ((const GAS f32x4*)gpost)[i]; gl[1024 + i] = ((const GAS f32x4*)g2)[i]; }
    LDS_WAIT(); __syncthreads();
    const int gw = F.vcu * NWAVES + F.wave, NGW = F.G * NWAVES, lane = F.lane;
    for (int m = gw; m < M; m += NGW) {
        const GAS f32x4* br = (const GAS f32x4*)x_row(baseP, baseS, m) + lane;
        const GAS v2u* yr = (const GAS v2u*)(Y + (size_t)m * D) + lane;
        const float ssy = wave_sum(stats[(size_t)m * 64 + lane]);
        const float ry = c / sqrtf(ssy * (1.f / D) + EPS);
        f32x4 h[16]; float s = 0.f;
#pragma unroll
        for (int j = 0; j < 16; ++j) { const f32x4 b = br[64 * j]; const v2u yy = yr[64 * j]; const f32x4 gp = gl[64 * j + lane];
            f32x4 y; y.x = bf_lo(yy.x); y.y = bf_hi(yy.x); y.z = bf_lo(yy.y); y.w = bf_hi(yy.y);
            h[j] = b + y * ry * gp; s += (h[j].x * h[j].x + h[j].y * h[j].y) + (h[j].z * h[j].z + h[j].w * h[j].w); }
        const float rh = 1.0f / sqrtf(wave_sum(s) * (1.f / D) + EPS);
        GAS f32x4* ho = (GAS f32x4*)(H + (size_t)m * D) + lane;
        if constexpr (FINAL) {
#pragma unroll
            for (int j = 0; j < 16; ++j) { const f32x4 gg = gl[1024 + 64 * j + lane]; ho[64 * j] = h[j] * rh * gg; }
        } else {
            GAS v2u* ao = (GAS v2u*)(A + (size_t)m * D) + lane;
#pragma unroll
            for (int j = 0; j < 16; ++j) { const f32x4 gg = gl[1024 + 64 * j + lane]; ho[64 * j] = h[j];
                v2u w; w.x = pk2(h[j].x * rh * gg.x, h[j].y * rh * gg.y); w.y = pk2(h[j].z * rh * gg.z, h[j].w * rh * gg.w); ao[64 * j] = w; }
        }
    }
}

__device__ __forceinline__ void spatial_unit(Frame& F, int cidx, int h, const bf16* Z, const bf16* WSP, const float* b_sp, const float* v_norm, bf16* YCAT) {
    constexpr int VS = 136;
    LAS bf16* vT = (LAS bf16*)(F.lds + RING_OFF);
    const int r0 = cidx * CH, tid = F.tid;
    {   const int s = tid >> 2, q = tid & 3;
        const GAS v4u* src = (const GAS v4u*)(Z + (size_t)(r0 + s) * DIN + DA + h * HD + q * 32);
        v4u w[4];
#pragma unroll
        for (int i = 0; i < 4; ++i) w[i] = src[i];
        float v[32]; float ss = 0.f;
#pragma unroll
        for (int i = 0; i < 4; ++i) { v[8 * i + 0] = bf_lo(w[i].x); v[8 * i + 1] = bf_hi(w[i].x); v[8 * i + 2] = bf_lo(w[i].y); v[8 * i + 3] = bf_hi(w[i].y);
            v[8 * i + 4] = bf_lo(w[i].z); v[8 * i + 5] = bf_hi(w[i].z); v[8 * i + 6] = bf_lo(w[i].w); v[8 * i + 7] = bf_hi(w[i].w); }
#pragma unroll
        for (int j = 0; j < 32; ++j) ss += v[j] * v[j];
        ss += __shfl_xor(ss, 1); ss += __shfl_xor(ss, 2);
        const float r = 1.0f / sqrtf(ss * (1.f / HD) + EPS);
        const GAS f32x4* vn = (const GAS f32x4*)(v_norm + h * HD + q * 32);
#pragma unroll
        for (int j4 = 0; j4 < 8; ++j4) { const f32x4 gn = vn[j4];
            vT[(q * 32 + 4 * j4 + 0) * VS + s] = (bf16)f2bf(v[4 * j4 + 0] * r * gn.x); vT[(q * 32 + 4 * j4 + 1) * VS + s] = (bf16)f2bf(v[4 * j4 + 1] * r * gn.y);
            vT[(q * 32 + 4 * j4 + 2) * VS + s] = (bf16)f2bf(v[4 * j4 + 2] * r * gn.z); vT[(q * 32 + 4 * j4 + 3) * VS + s] = (bf16)f2bf(v[4 * j4 + 3] * r * gn.w); }
    }
    LDS_WAIT(); __syncthreads();
    {   const int w = F.wave, fr = F.lane & 15, fq = F.lane >> 4, t = 16 * w + fr;
        bf16x8 af[4];
#pragma unroll
        for (int kk = 0; kk < 4; ++kk) af[kk] = *(const GAS bf16x8*)(WSP + (size_t)h * CH * CH + t * CH + kk * 32 + fq * 8);
        f32x4 acc[8];
#pragma unroll
        for (int n = 0; n < 8; ++n) { acc[n] = (f32x4){0.f, 0.f, 0.f, 0.f};
#pragma unroll
            for (int kk = 0; kk < 4; ++kk) { const bf16x8 bfr = *(const LAS bf16x8*)(vT + (16 * n + fr) * VS + kk * 32 + fq * 8);
                acc[n] = __builtin_amdgcn_mfma_f32_16x16x32_bf16(bfr, af[kk], acc[n], 0, 0, 0); } }
        const float bias = b_sp[h * CH + t];
        const GAS v2u* ur = (const GAS v2u*)(Z + (size_t)(r0 + t) * DIN + h * HD + 4 * fq);
        GAS v2u* orow = (GAS v2u*)(YCAT + (size_t)(r0 + t) * D + h * HD + 4 * fq);
#pragma unroll
        for (int n = 0; n < 8; ++n) { const v2u uu = ur[4 * n];
            v2u o; o.x = pk2(bf_lo(uu.x) * (acc[n][0] + bias), bf_hi(uu.x) * (acc[n][1] + bias)); o.y = pk2(bf_lo(uu.y) * (acc[n][2] + bias), bf_hi(uu.y) * (acc[n][3] + bias));
            orow[4 * n] = o; }
    }
    LDS_WAIT(); __syncthreads();
}

__device__ __forceinline__ void pool_strip(const bf16* Z, bf16* PB, int strip, int cg) {
    const int m0 = strip * 16;
    const int s0 = (m0 < M_PROMPT) ? (m0 & ~(SEQ_P - 1)) : (M_PROMPT + ((m0 - M_PROMPT) & ~(SEQ_S - 1)));
    const int len = (m0 < M_PROMPT) ? SEQ_P : SEQ_S;
    const int hw = 1 << (cg >> 6);
    const bf16* zc = Z + (size_t)s0 * DIN + 2 * DA + 8 * cg;
    float S[8];
#pragma unroll
    for (int i = 0; i < 8; ++i) S[i] = 0.f;
    const int t0 = m0 - s0;
    {   const int lo = (t0 - hw) > 0 ? (t0 - hw) : 0, hi = (t0 + hw) < len ? (t0 + hw) : len;
        for (int r = lo; r < hi; ++r) { const v4u w = *(const GAS v4u*)(zc + (size_t)r * DIN);
            S[0] += bf_lo(w.x); S[1] += bf_hi(w.x); S[2] += bf_lo(w.y); S[3] += bf_hi(w.y); S[4] += bf_lo(w.z); S[5] += bf_hi(w.z); S[6] += bf_lo(w.w); S[7] += bf_hi(w.w); } }
    for (int i = 0; i < 16; ++i) { const int t = t0 + i;
        const int lo = (t - hw) > 0 ? (t - hw) : 0, hi = (t + hw) < len ? (t + hw) : len;
        const float inv = 1.0f / (float)(hi - lo);
        const v4u w = *(const GAS v4u*)(zc + (size_t)t * DIN);
        v4u o; o.x = pk2(S[0] * inv - bf_lo(w.x), S[1] * inv - bf_hi(w.x)); o.y = pk2(S[2] * inv - bf_lo(w.y), S[3] * inv - bf_hi(w.y));
        o.z = pk2(S[4] * inv - bf_lo(w.z), S[5] * inv - bf_hi(w.z)); o.w = pk2(S[6] * inv - bf_lo(w.w), S[7] * inv - bf_hi(w.w));
        *(GAS v4u*)(PB + (size_t)(s0 + t) * DB + 8 * cg) = o;
        if (i < 15) {
            if (t + hw < len) { const v4u a = *(const GAS v4u*)(zc + (size_t)(t + hw) * DIN);
                S[0] += bf_lo(a.x); S[1] += bf_hi(a.x); S[2] += bf_lo(a.y); S[3] += bf_hi(a.y); S[4] += bf_lo(a.z); S[5] += bf_hi(a.z); S[6] += bf_lo(a.w); S[7] += bf_hi(a.w); }
            if (t - hw >= 0) { const v4u a = *(const GAS v4u*)(zc + (size_t)(t - hw) * DIN);
                S[0] -= bf_lo(a.x); S[1] -= bf_hi(a.x); S[2] -= bf_lo(a.y); S[3] -= bf_hi(a.y); S[4] -= bf_lo(a.z); S[5] -= bf_hi(a.z); S[6] -= bf_lo(a.w); S[7] -= bf_hi(a.w); } }
    }
}

struct Args { const float* in[22]; float* out; unsigned char* ws; int ph_lo, ph_hi; };
__global__ void __launch_bounds__(NWAVES * 64, 2) mk_fwd(Args args) {
    extern __shared__ __attribute__((aligned(16))) unsigned char lds[];
    Frame F;
    F.lds = (LAS unsigned char*)lds;
    F.MISC = (volatile LAS unsigned*)(F.lds + MISC_OFF);
    F.tid = threadIdx.x; F.lane = F.tid & 63; F.wave = __builtin_amdgcn_readfirstlane(F.tid >> 6);
    F.G = gridDim.x; { const int bx = blockIdx.x; F.vcu = (F.G % 8 == 0) ? (bx % 8) * (F.G / 8) + bx / 8 : bx; }
    unsigned char* ws = args.ws;
    F.ctl = (gu32*)(ws + WS_CTL);
    for (int u = F.tid; u < (LDS_BYTES - LDSCTL_OFF) / 4; u += NWAVES * 64) ((LAS unsigned*)(F.lds + LDSCTL_OFF))[u] = 0u;
    __syncthreads();
    XcdBarrier bar; bar.bar = (unsigned*)(F.ctl + CW_BAR); bar.x = 0; bar.st = nullptr;
    if (N_LAUNCHES == 1) bar = xcd_barrier_post((unsigned*)(F.ctl + CW_BAR), F.MISC + 8);
#define GRID_BAR() do { if (N_LAUNCHES == 1) xcd_barrier(bar); } while (0)

    const float* x_p = args.in[0]; const float* x_s = args.in[1];
    bf16* WGU1 = (bf16*)(ws + WS_WGU1); bf16* WD1 = (bf16*)(ws + WS_WD1); bf16* WGU2 = (bf16*)(ws + WS_WGU2); bf16* WD2 = (bf16*)(ws + WS_WD2);
    bf16* WIN = (bf16*)(ws + WS_WIN); bf16* WOUT = (bf16*)(ws + WS_WOUT); bf16* WSP = (bf16*)(ws + WS_WSP); bf16* WPT = (bf16*)(ws + WS_WPT);
    bf16* AB = (bf16*)(ws + WS_A); bf16* PB = (bf16*)(ws + WS_A); bf16* HID = (bf16*)(ws + WS_HID); bf16* ZB = (bf16*)(ws + WS_Z); bf16* YCAT = (bf16*)(ws + WS_YCAT); bf16* YB = (bf16*)(ws + WS_Y);
    float* STATS = (float*)(ws + WS_STATS); float* H = args.out;

    const int lo = args.ph_lo, hi = args.ph_hi;
#define IN(k) (lo <= (k) && (k) < hi)
#define BOTH(k) (IN(k) && IN((k) + 1))

    if (IN(0)) {
        LAS float* scr = (LAS float*)(F.lds + RING_OFF + F.wave * 16384);
        const int gw = F.vcu * NWAVES + F.wave, NGW = F.G * NWAVES;
        constexpr int I_GU = (D / 64) * (FF / 32), I_D = (FF / 64) * (D / 32), I_IN = (D / 64) * (DIN / 32), I_OUT = (D / 64) * (D / 32), I_P = (DPG / 64) * (DPG / 32);
        constexpr int NITEMS = 4 * I_GU + 2 * I_D + I_IN + I_OUT + 4 * I_P;
        for (int it = gw; it < NITEMS; it += NGW) {
            int r = it;
            if (r < I_GU) { p0_transpose_item(args.in[4], D, FF, WGU1, 1, 0, scr, r, F.lane); continue; } r -= I_GU;
            if (r < I_GU) { p0_transpose_item(args.in[5], D, FF, WGU1, 2, 0, scr, r, F.lane); continue; } r -= I_GU;
            if (r < I_D) { p0_transpose_item(args.in[6], FF, D, WD1, 0, 0, scr, r, F.lane); continue; } r -= I_D;
            if (r < I_GU) { p0_transpose_item(args.in[18], D, FF, WGU2, 1, 0, scr, r, F.lane); continue; } r -= I_GU;
            if (r < I_GU) { p0_transpose_item(args.in[19], D, FF, WGU2, 2, 0, scr, r, F.lane); continue; } r -= I_GU;
            if (r < I_D) { p0_transpose_item(args.in[20], FF, D, WD2, 0, 0, scr, r, F.lane); continue; } r -= I_D;
            if (r < I_IN) { p0_transpose_item(args.in[9], D, DIN, WIN, 0, 0, scr, r, F.lane); continue; } r -= I_IN;
            if (r < I_OUT) { p0_transpose_item(args.in[15], D, D, WOUT, 0, 0, scr, r, F.lane); continue; } r -= I_OUT;
            { const int gp = r / I_P; p0_transpose_item(args.in[13] + (size_t)gp * DPG * DPG, DPG, DPG, WPT, 0, gp * DPG, scr, r % I_P, F.lane); }
        }
        for (int i = (blockIdx.x * NWAVES * 64 + F.tid); i < NH * CH * CH / 4; i += F.G * NWAVES * 64) {
            const f32x4 v = ((const GAS f32x4*)args.in[10])[i]; v2u w; w.x = pk2(v.x, v.y); w.y = pk2(v.z, v.w); ((GAS v2u*)WSP)[i] = w; }
        for (int m = gw; m < M; m += NGW) rms_row_to_bf16(F.lane, x_row(x_p, x_s, m), args.in[2], AB + (size_t)m * D);
        if (BOTH(0)) GRID_BAR();
    }
    if (IN(1)) {
        pg8::Gemm g{AB, WGU1, D, D, D, 0}; pg8::StaticOrder S; S.init(M, NGU, F.G, (int)blockIdx.x);
        pg8::EpiSwiGLU E{HID, FF};
        pg8::gemm_phase<pg8::EpiSwiGLU, pg8::StaticOrder, true>(F.lds + RING_OFF, g, S, E);
        if (BOTH(1)) GRID_BAR();
    }
    if (IN(2)) {
        pg8::Gemm g{HID, WD1, FF, FF, FF, 0}; pg8::StaticOrder S; S.init(M, D, F.G, (int)blockIdx.x);
        pg8::EpiYStats E{YB, D, STATS};
        pg8::gemm_phase<pg8::EpiYStats, pg8::StaticOrder, true>(F.lds + RING_OFF, g, S, E);
        if (BOTH(2)) GRID_BAR();
    }
    if (IN(3)) {
        norm_phase<false>(F, x_p, x_s, YB, STATS, 0.5f, args.in[3], args.in[7], H, AB);
        if (BOTH(3)) GRID_BAR();
    }
    if (IN(4)) {
        pg8::Gemm g{AB, WIN, D, D, D, 0}; pg8::StaticOrder S; S.init(M, DIN, F.G, (int)blockIdx.x);
        pg8::EpiZ E{ZB, DIN, (2 * DA) / 256};
        pg8::gemm_phase<pg8::EpiZ, pg8::StaticOrder, true>(F.lds + RING_OFF, g, S, E);
        if (BOTH(4)) GRID_BAR();
    }
    if (IN(5)) {
        constexpr int NUNITS = (M / CH) * NH;
        const int per = (NUNITS + F.G - 1) / F.G;
        for (int i = 0; i < per; ++i) { const int uidx = F.vcu * per + i; if (uidx < NUNITS) spatial_unit(F, uidx / NH, uidx % NH, ZB, WSP, args.in[11], args.in[12], YCAT); }
        constexpr int NSTRIPS = M / 16;
        for (int sp = F.vcu * 2 + (F.tid >> 8); sp < NSTRIPS; sp += F.G * 2) pool_strip(ZB, PB, sp, F.tid & 255);
        if (BOTH(5)) GRID_BAR();
    }
    if (IN(6)) {
        pg8::Gemm g{PB, WPT, DB, DPG, DPG, DPG}; pg8::StaticOrder S; S.init(M, DB, F.G, (int)blockIdx.x);
        pg8::EpiScale E{YCAT, D, DA, args.in[14]};
        pg8::gemm_phase<pg8::EpiScale, pg8::StaticOrder, true>(F.lds + RING_OFF, g, S, E);
        if (BOTH(6)) GRID_BAR();
    }
    if (IN(7)) {
        pg8::Gemm g{YCAT, WOUT, D, D, D, 0}; pg8::StaticOrder S; S.init(M, D, F.G, (int)blockIdx.x);
        pg8::EpiYStats E{YB, D, STATS};
        pg8::gemm_phase<pg8::EpiYStats, pg8::StaticOrder, true>(F.lds + RING_OFF, g, S, E);
        if (BOTH(7)) GRID_BAR();
    }
    if (IN(8)) {
        norm_phase<false>(F, H, H + (size_t)M_PROMPT * D, YB, STATS, 1.0f, args.in[8], args.in[16], H, AB);
        if (BOTH(8)) GRID_BAR();
    }
    if (IN(9)) {
        pg8::Gemm g{AB, WGU2, D, D, D, 0}; pg8::StaticOrder S; S.init(M, NGU, F.G, (int)blockIdx.x);
        pg8::EpiSwiGLU E{HID, FF};
        pg8::gemm_phase<pg8::EpiSwiGLU, pg8::StaticOrder, true>(F.lds + RING_OFF, g, S, E);
        if (BOTH(9)) GRID_BAR();
    }
    if (IN(10)) {
        pg8::Gemm g{HID, WD2, FF, FF, FF, 0}; pg8::StaticOrder S; S.init(M, D, F.G, (int)blockIdx.x);
        pg8::EpiYStats E{YB, D, STATS};
        pg8::gemm_phase<pg8::EpiYStats, pg8::StaticOrder, true>(F.lds + RING_OFF, g, S, E);
        if (BOTH(10)) GRID_BAR();
    }
    if (IN(11)) {
        norm_phase<true>(F, H, H + (size_t)M_PROMPT * D, YB, STATS, 0.5f, args.in[17], args.in[21], H, nullptr);
    }
#undef IN
#undef BOTH
#undef GRID_BAR
}

extern "C" void kernel_launch(void* const* d_in, const int* in_sizes, int n_in, void* d_out, int out_size, void* d_ws, size_t ws_size, hipStream_t stream) {
    static int grid = 0;
    if (grid == 0) {
        if (n_in != 22 || in_sizes[0] != M_PROMPT * D || out_size != M * D || ws_size < WS_END) {
            fprintf(stderr, "kernel_launch: shape/workspace mismatch: n_in %d in0 %d out %d ws %zu (need %zu); nothing launched\n", n_in, n_in > 0 ? in_sizes[0] : -1, out_size, ws_size, (size_t)WS_END); grid = -1; return; }
        int dev = 0, cus = 0, per_cu = 0;
        if (hipGetDevice(&dev) != hipSuccess || hipDeviceGetAttribute(&cus, hipDeviceAttributeMultiprocessorCount, dev) != hipSuccess) { fprintf(stderr, "kernel_launch: device query failed\n"); grid = -1; return; }
        if (hipFuncSetAttribute((const void*)mk_fwd, hipFuncAttributeMaxDynamicSharedMemorySize, LDS_BYTES) != hipSuccess) { fprintf(stderr, "kernel_launch: hipFuncSetAttribute failed\n"); grid = -1; return; }
        if (hipOccupancyMaxActiveBlocksPerMultiprocessor(&per_cu, (const void*)mk_fwd, NWAVES * 64, LDS_BYTES) != hipSuccess || per_cu < 1) {
            fprintf(stderr, "kernel_launch: occupancy query reports %d workgroups per CU\n", per_cu); }
        (void)hipGetLastError();
        grid = cus;
    }
    if (grid < 0) return;
    if (hipMemsetAsync((char*)d_ws + WS_CTL, 0, CTL_ZERO_BYTES, stream) != hipSuccess) { fprintf(stderr, "kernel_launch: memset failed\n"); return; }
    Args a{};
    for (int i = 0; i < 22; ++i) a.in[i] = (const float*)d_in[i];
    a.out = (float*)d_out; a.ws = (unsigned char*)d_ws;
    if (N_LAUNCHES == 1) { a.ph_lo = 0; a.ph_hi = N_PHASES; hipLaunchKernelGGL(mk_fwd, dim3(grid), dim3(NWAVES * 64), LDS_BYTES, stream, a); }
    else for (int li = 0; li < N_PHASES; ++li) { a.ph_lo = li; a.ph_hi = li + 1; hipLaunchKernelGGL(mk_fwd, dim3(grid), dim3(NWAVES * 64), LDS_BYTES, stream, a); }
    const hipError_t le = hipPeekAtLastError();
    if (le != hipSuccess) fprintf(stderr, "kernel_launch: launch failed: %s\n", hipGetErrorName(le));
}
```

```cpp
#include <hip/hip_runtime.h>
#include <cstdio>
#include <cstdint>

namespace pg8 {
#define PG8_LAS __attribute__((address_space(3)))
typedef unsigned short bf16_t;
typedef short bf16x8 __attribute__((ext_vector_type(8)));
typedef float f32x4 __attribute__((ext_vector_type(4)));
typedef float f32x2 __attribute__((ext_vector_type(2)));
typedef unsigned u32x4 __attribute__((ext_vector_type(4)));
typedef unsigned u32x2 __attribute__((ext_vector_type(2)));
typedef int i32x4 __attribute__((ext_vector_type(4)));
constexpr int BM = 256, BK = 64, HALF = 128, HTB = HALF * BK * 2  , STAGE_BYTES = 8 * HTB, NXCD = 8, WGM = 8;

__host__ __device__ __forceinline__ int lds_byte(int r, int c) { const int st = (r >> 4) * 2 + (c >> 5), rr = r & 15, cc = c & 31, ob = rr * 64 + cc * 2; return st * 1024 + (ob ^ (((ob >> 9) & 1) << 5)); }
__host__ __device__ __forceinline__ void stage_rc(int b, int& R, int& C) { const int st = b / 1024, sb = b % 1024, swz = sb ^ (((sb >> 9) & 1) << 5); R = (st >> 1) * 16 + swz / 64; C = (st & 1) * 32 + (swz % 64) / 2; }
__host__ __device__ __forceinline__ int perm32(int rho) { const int n = rho >> 4, i = rho & 15; return 8 * (i >> 2) + 4 * n + (i & 3); }

struct Unit { int pm, pn; };
struct Gemm { const void* A; const void* Bt; int ldaB, ldbB, KB, a_cbytes, kstepA, kstepB; size_t tstepA, tstepB; };
__host__ __device__ __forceinline__ Gemm gemm_rm(const void* A, const void* Bt, int ldaB, int ldbB, int KB, int a_cbytes = 0) { return Gemm{A, Bt, ldaB, ldbB, KB, a_cbytes, 128, 128, (size_t)256 * ldaB, (size_t)256 * ldbB}; }
constexpr int TILE_BYTES = 32768;
__host__ __device__ __forceinline__ Gemm gemm_tiled(const void* A, const void* Bt, int KB) { return Gemm{A, Bt, 128, 128, KB, 0, TILE_BYTES, TILE_BYTES, (size_t)256 * KB, (size_t)256 * KB}; }

struct StaticOrder {
    int nM, nN, nwg, G, c, wgm, rev;
    __host__ __device__ void init(int M, int N, int G_, int c_, int wgm_ = WGM, int rev_ = 0) { nM = M / BM; nN = N / BM; nwg = nM * nN; G = G_; c = c_; wgm = wgm_; rev = rev_; }
    __host__ __device__ bool next(int i, Unit& u) const {
        const long L = (long)i * G + c; if (L >= nwg) return false;
        int wgid = (int)L; { const int q = nwg / NXCD, r = nwg % NXCD, xcd = wgid % NXCD, cnt = xcd < r ? q + 1 : q; int off = wgid / NXCD; if (rev) off = cnt - 1 - off; wgid = (xcd < r ? xcd * (q + 1) : r * (q + 1) + (xcd - r) * q) + off; }
        const int nig = wgm * nN, gid = wgid / nig, fm = gid * wgm, gsz = (nM - fm) < wgm ? (nM - fm) : wgm;
        u.pm = fm + ((wgid % nig) % gsz); u.pn = (wgid % nig) / gsz; return true;
    }
    __device__ __forceinline__ void a_ready(const Unit&) const {}
    __device__ __forceinline__ void done(const Unit&) const {}
};

struct MixOrder : StaticOrder {
    __device__ bool next(int i, Unit& u) const { if (!StaticOrder::next(i, u)) return false; const int p = u.pn, q = p / 3, r = p - 3 * q; u.pn = (r < 2) ? 2 * q + r : 16 + q; return true; }
};
__device__ __forceinline__ unsigned cvt_pk_bf16(float lo, float hi) { unsigned r; asm volatile("v_cvt_pk_bf16_f32 %0, %1, %2" : "=v"(r) : "v"(lo), "v"(hi)); return r; }
__device__ __forceinline__ f32x2 gelu_pk(f32x2 v) {
    const f32x2 av = __builtin_elementwise_abs(v), d = av * 0.2316418882f + 1.0f;
    f32x2 t; t.x = __builtin_amdgcn_rcpf(d.x); t.y = __builtin_amdgcn_rcpf(d.y);
    f32x2 q = t * 0.5307027145f + (-0.7265760135f); q = q * t + 0.7107068705f; q = q * t + (-0.142248368f); q = q * t + 0.127414796f; q = q * t;
    const f32x2 s = (v * v) * (-0.72134752044f);
    f32x2 e; e.x = __builtin_amdgcn_exp2f(s.x); e.y = __builtin_amdgcn_exp2f(s.y);
    const f32x2 m = v * (q * e), r = v - m;
    f32x2 o; o.x = v.x < 0.f ? m.x : r.x; o.y = v.y < 0.f ? m.y : r.y; return o;
}
__device__ __forceinline__ float silu_f(float g) { return g * __builtin_amdgcn_rcpf(1.0f + __builtin_amdgcn_exp2f(-1.44269504f * g)); }

struct EpiSwiGLU {
    static constexpr bool PERM = true, AFTER_DRAIN = false, I8 = false; typedef f32x4 acc_t;
    bf16_t* O; int ldc;
    __device__ __forceinline__ void operator()(const f32x4 (&acc)[2][2][4][2], const Unit& u, int wr, int wc, int fr, int fq) const {
        const int row0 = u.pm * BM + wr * 64 + fr, col0 = u.pn * HALF + wc * 32 + 8 * fq;
#pragma unroll
        for (int ai = 0; ai < 2; ++ai)
#pragma unroll
            for (int m = 0; m < 4; ++m) { bf16_t* rowp = O + (size_t)(row0 + ai * HALF + m * 16) * ldc + col0;
                const f32x4 g0 = acc[ai][0][m][0], g1 = acc[ai][0][m][1], u0 = acc[ai][1][m][0], u1 = acc[ai][1][m][1];
                u32x4 w;
                w.x = cvt_pk_bf16(silu_f(g0[0]) * u0[0], silu_f(g0[1]) * u0[1]); w.y = cvt_pk_bf16(silu_f(g0[2]) * u0[2], silu_f(g0[3]) * u0[3]);
                w.z = cvt_pk_bf16(silu_f(g1[0]) * u1[0], silu_f(g1[1]) * u1[1]); w.w = cvt_pk_bf16(silu_f(g1[2]) * u1[2], silu_f(g1[3]) * u1[3]);
                *(u32x4*)rowp = w; }
    }
};
struct EpiSwiGLUQ {
    static constexpr bool PERM = true, AFTER_DRAIN = false, I8 = true; typedef i32x4 acc_t;
    bf16_t* O; int ldc; const float* sa; const float* sw;
    __device__ __forceinline__ static f32x4 act4(const i32x4 G, const i32x4 U, const f32x4 kL, const f32x4 kP) {
        const f32x4 gf = __builtin_convertvector(G, f32x4), uf = __builtin_convertvector(U, f32x4);
        const f32x4 t = gf * kL; f32x4 d;
        d.x = __builtin_amdgcn_exp2f(t.x); d.y = __builtin_amdgcn_exp2f(t.y); d.z = __builtin_amdgcn_exp2f(t.z); d.w = __builtin_amdgcn_exp2f(t.w);
        d = d + 1.0f; f32x4 r;
        r.x = __builtin_amdgcn_rcpf(d.x); r.y = __builtin_amdgcn_rcpf(d.y); r.z = __builtin_amdgcn_rcpf(d.z); r.w = __builtin_amdgcn_rcpf(d.w);
        return ((gf * uf) * kP) * r;
    }
    __device__ __forceinline__ void operator()(const i32x4 (&acc)[2][2][4][2], const Unit& u, int wr, int wc, int fr, int fq) const {
        const int row0 = u.pm * BM + wr * 64 + fr;
        const float* swp = sw + u.pn * BM + wc * 32 + 8 * fq;
        const f32x4 sg0 = *(const f32x4*)(swp), sg1 = *(const f32x4*)(swp + 4), su0 = *(const f32x4*)(swp + HALF), su1 = *(const f32x4*)(swp + HALF + 4);
        const f32x4 gu0 = sg0 * su0, gu1 = sg1 * su1;
        float sr[2][4];
#pragma unroll
        for (int ai = 0; ai < 2; ++ai)
#pragma unroll
            for (int m = 0; m < 4; ++m) sr[ai][m] = sa[row0 + ai * HALF + m * 16];
#pragma unroll
        for (int ai = 0; ai < 2; ++ai)
#pragma unroll
            for (int m = 0; m < 4; ++m) { const float s = sr[ai][m];
                bf16_t* rowp = (bf16_t*)((char*)O + ((size_t)u.pm * (ldc / 64) + 2 * u.pn + (wc >> 1)) * TILE_BYTES + (wr * 64 + fr + ai * HALF + m * 16) * 128 + ((wc & 1) * 32 + 8 * fq) * 2);
                const float sl = s * -1.44269504f, ss = s * s;
                const f32x4 o0 = act4(acc[ai][0][m][0], acc[ai][1][m][0], sg0 * sl, gu0 * ss), o1 = act4(acc[ai][0][m][1], acc[ai][1][m][1], sg1 * sl, gu1 * ss);
                u32x4 w; w.x = cvt_pk_bf16(o0[0], o0[1]); w.y = cvt_pk_bf16(o0[2], o0[3]); w.z = cvt_pk_bf16(o1[0], o1[1]); w.w = cvt_pk_bf16(o1[2], o1[3]);
                __builtin_nontemporal_store(w, (u32x4*)rowp); }
    }
};
struct EpiYStats {
    static constexpr bool PERM = true, AFTER_DRAIN = false, I8 = false; typedef f32x4 acc_t;
    bf16_t* O; int ldc; float* stats;
    __device__ __forceinline__ void operator()(const f32x4 (&acc)[2][2][4][2], const Unit& u, int wr, int wc, int fr, int fq) const {
        const int row0 = u.pm * BM + wr * 64 + fr, col0 = u.pn * BM + wc * 32 + 8 * fq;
#pragma unroll
        for (int ai = 0; ai < 2; ++ai)
#pragma unroll
            for (int m = 0; m < 4; ++m) { const int row = row0 + ai * HALF + m * 16; bf16_t* rowp = O + (size_t)row * ldc + col0; float ss = 0.f;
#pragma unroll
                for (int bj = 0; bj < 2; ++bj) { const f32x4 v0 = acc[ai][bj][m][0], v1 = acc[ai][bj][m][1];
                    ss += (v0[0] * v0[0] + v0[1] * v0[1]) + (v0[2] * v0[2] + v0[3] * v0[3]) + (v1[0] * v1[0] + v1[1] * v1[1]) + (v1[2] * v1[2] + v1[3] * v1[3]);
                    u32x4 w; w.x = cvt_pk_bf16(v0[0], v0[1]); w.y = cvt_pk_bf16(v0[2], v0[3]); w.z = cvt_pk_bf16(v1[0], v1[1]); w.w = cvt_pk_bf16(v1[2], v1[3]);
                    *(u32x4*)(rowp + bj * HALF) = w; }
                ss += __shfl_xor(ss, 16); ss += __shfl_xor(ss, 32);
                if (fq == 0) stats[(size_t)row * 64 + u.pn * 4 + wc] = ss; }
    }
};
struct EpiZ {
    static constexpr bool PERM = true, AFTER_DRAIN = false, I8 = false; typedef f32x4 acc_t;
    bf16_t* O; int ldc; int gelu_tiles; const float* rs;
    __device__ __forceinline__ void operator()(const f32x4 (&acc)[2][2][4][2], const Unit& u, int wr, int wc, int fr, int fq) const {
        const int row0 = u.pm * BM + wr * 64 + fr, col0 = u.pn * BM + wc * 32 + 8 * fq; const bool act = u.pn < gelu_tiles;
        float sr[2][4];
#pragma unroll
        for (int ai = 0; ai < 2; ++ai)
#pragma unroll
            for (int m = 0; m < 4; ++m) sr[ai][m] = rs[row0 + ai * HALF + m * 16];
#pragma unroll
        for (int ai = 0; ai < 2; ++ai)
#pragma unroll
            for (int m = 0; m < 4; ++m) { bf16_t* rowp = O + (size_t)(row0 + ai * HALF + m * 16) * ldc + col0; const float s = sr[ai][m];
#pragma unroll
                for (int bj = 0; bj < 2; ++bj) { f32x4 v0 = acc[ai][bj][m][0] * s, v1 = acc[ai][bj][m][1] * s;
                    if (act) { const f32x2 a = gelu_pk((f32x2){v0[0], v0[1]}), b = gelu_pk((f32x2){v0[2], v0[3]}), c = gelu_pk((f32x2){v1[0], v1[1]}), d = gelu_pk((f32x2){v1[2], v1[3]});
                        v0 = (f32x4){a.x, a.y, b.x, b.y}; v1 = (f32x4){c.x, c.y, d.x, d.y}; }
                    u32x4 w; w.x = cvt_pk_bf16(v0[0], v0[1]); w.y = cvt_pk_bf16(v0[2], v0[3]); w.z = cvt_pk_bf16(v1[0], v1[1]); w.w = cvt_pk_bf16(v1[2], v1[3]);
                    *(u32x4*)(rowp + bj * HALF) = w; } }
    }
};
struct EpiScale {
    static constexpr bool PERM = true, AFTER_DRAIN = false, I8 = false; typedef f32x4 acc_t;
    bf16_t* O; int ldc; int ocol; const float* scale;
    __device__ __forceinline__ void operator()(const f32x4 (&acc)[2][2][4][2], const Unit& u, int wr, int wc, int fr, int fq) const {
        const int row0 = u.pm * BM + wr * 64 + fr, col0 = u.pn * BM + wc * 32 + 8 * fq;
        f32x4 sv[2][2];
#pragma unroll
        for (int bj = 0; bj < 2; ++bj)
#pragma unroll
            for (int n = 0; n < 2; ++n) sv[bj][n] = *(const f32x4*)(scale + col0 + bj * HALF + 4 * n);
#pragma unroll
        for (int ai = 0; ai < 2; ++ai)
#pragma unroll
            for (int m = 0; m < 4; ++m) { bf16_t* rowp = O + (size_t)(row0 + ai * HALF + m * 16) * ldc + ocol + col0;
#pragma unroll
                for (int bj = 0; bj < 2; ++bj) { const f32x4 v0 = acc[ai][bj][m][0] * sv[bj][0], v1 = acc[ai][bj][m][1] * sv[bj][1];
                    u32x4 w; w.x = cvt_pk_bf16(v0[0], v0[1]); w.y = cvt_pk_bf16(v0[2], v0[3]); w.z = cvt_pk_bf16(v1[0], v1[1]); w.w = cvt_pk_bf16(v1[2], v1[3]);
                    *(u32x4*)(rowp + bj * HALF) = w; } }
    }
};

template <bool I8> __device__ __forceinline__ f32x4 mma1(i32x4 b, i32x4 a, f32x4 c) { return __builtin_amdgcn_mfma_f32_16x16x32_bf16(__builtin_bit_cast(bf16x8, b), __builtin_bit_cast(bf16x8, a), c, 0, 0, 0); }
template <bool I8> __device__ __forceinline__ i32x4 mma1(i32x4 b, i32x4 a, i32x4 c) { return __builtin_amdgcn_mfma_i32_16x16x64_i8(b, a, c, 0, 0, 0); }
template <class Epi, class Sched, bool ALIGN_EPI>
__device__ __forceinline__ void gemm_phase(PG8_LAS unsigned char* lds, const Gemm g, const Sched& S, const Epi& E) {
    const int tid = threadIdx.x, wid = __builtin_amdgcn_readfirstlane(tid >> 6), lane = tid & 63, wr = wid >> 2, wc = wid & 3, fr = lane & 15, fq = lane >> 4;
    const int nt = g.KB / (BK * 2);
    typedef typename Epi::acc_t acc_t; typedef i32x4 frag_t;
    unsigned voffA[2], voffB[2];
#pragma unroll
    for (int i = 0; i < 2; ++i) { int R, C; stage_rc(tid * 16 + i * 8192, R, C); const int Rb = Epi::PERM ? ((R & ~31) + perm32(R & 31)) : R;
        voffA[i] = (unsigned)(R * g.ldaB + C * 2); voffB[i] = (unsigned)(Rb * g.ldbB + C * 2); }
    const size_t kstepA = (size_t)g.kstepA, kstepB = (size_t)g.kstepB;
    const size_t hstepA = (size_t)HALF * g.ldaB, hstepB = (size_t)HALF * g.ldbB;
    const size_t tstepA = g.tstepA, tstepB = g.tstepB;
    const size_t acstep = (size_t)g.a_cbytes;
    const unsigned ldsw = (unsigned)wid * 1024u;
    const int aoff = lds_byte(wr * 64 + fr, fq * 8), boff = lds_byte(wc * 32 + fr, fq * 8);
#define PG8_SA(b, h) (((b) * 2 + (h)) * HTB)
#define PG8_SB(b, h) ((4 + (b) * 2 + (h)) * HTB)
#define PG8_STAGE(bufoff, gbase, voff) do { _Pragma("unroll") for (int _i = 0; _i < 2; ++_i) \
        __builtin_amdgcn_global_load_lds((const unsigned*)((const char*)(gbase) + (voff)[_i]), (PG8_LAS unsigned*)(lds + (bufoff) + ldsw + _i * 8192), 16, 0, 0); } while (0)
#define PG8_LDA(dst, b, h) do { _Pragma("unroll") for (int m = 0; m < 4; ++m) _Pragma("unroll") for (int k = 0; k < 2; ++k) dst[m][k] = *(const PG8_LAS frag_t*)(lds + PG8_SA(b, h) + aoff + m * 2048 + k * 1024); } while (0)
#define PG8_LDB(dst, b, h) do { _Pragma("unroll") for (int n = 0; n < 2; ++n) _Pragma("unroll") for (int k = 0; k < 2; ++k) dst[n][k] = *(const PG8_LAS frag_t*)(lds + PG8_SB(b, h) + boff + n * 2048 + k * 1024); } while (0)
#define PG8_MMA(ai, bj, At, Bt) do { __builtin_amdgcn_s_setprio(1); _Pragma("unroll") for (int m = 0; m < 4; ++m) _Pragma("unroll") for (int n = 0; n < 2; ++n) _Pragma("unroll") for (int k = 0; k < 2; ++k) \
        acc[ai][bj][m][n] = mma1<Epi::I8>(Bt[n][k], At[m][k], acc[ai][bj][m][n]); __builtin_amdgcn_s_setprio(0); } while (0)
#define PG8_WAIT_V(n) asm volatile("s_waitcnt vmcnt(" #n ")" ::: "memory")
#define PG8_WAIT_L(n) asm volatile("s_waitcnt lgkmcnt(" #n ")" ::: "memory")
#define PG8_BAR __builtin_amdgcn_s_barrier()
#define PG8_SCHED __builtin_amdgcn_sched_barrier(0)
#define PG8_UA(u) ((const char*)g.A + (size_t)(u).pm * tstepA + (size_t)((u).pn >> 1) * acstep)
#define PG8_UB(u) ((const char*)g.Bt + (size_t)(u).pn * tstepB)
    Unit cur, nxt; int ui = 0;
    if (!S.next(0, cur)) return;
    acc_t acc[2][2][4][2];
#pragma unroll
    for (int a = 0; a < 2; ++a)
#pragma unroll
        for (int b = 0; b < 2; ++b)
#pragma unroll
            for (int m = 0; m < 4; ++m)
#pragma unroll
                for (int n = 0; n < 2; ++n) acc[a][b][m][n] = (acc_t){0, 0, 0, 0};
    frag_t At[4][2], B0[2][2], B1[2][2];
    const char* cA = PG8_UA(cur); const char* cB = PG8_UB(cur);
    S.a_ready(cur);
    PG8_STAGE(PG8_SB(0, 0), cB, voffB); PG8_STAGE(PG8_SB(0, 1), cB + hstepB, voffB); PG8_STAGE(PG8_SA(0, 0), cA, voffA); PG8_STAGE(PG8_SA(0, 1), cA + hstepA, voffA);
    if (wr == 1) PG8_BAR;
    PG8_WAIT_V(2); PG8_BAR;
    PG8_STAGE(PG8_SB(1, 0), cB + kstepB, voffB); PG8_STAGE(PG8_SA(1, 0), cA + kstepA, voffA); PG8_STAGE(PG8_SB(1, 1), cB + hstepB + kstepB, voffB);
    PG8_WAIT_V(6); PG8_BAR;
    for (;;) {
        const bool has_next = S.next(ui + 1, nxt);
        const char* nA = has_next ? PG8_UA(nxt) : cA; const char* nB = has_next ? PG8_UB(nxt) : cB;
        for (int t = 0; t < nt; t += 2) {
            const bool last = (t == nt - 2);
            const char* a1 = cA + (size_t)(t + 1) * kstepA;
            const char* a2 = last ? nA : cA + (size_t)(t + 2) * kstepA; const char* b2 = last ? nB : cB + (size_t)(t + 2) * kstepB;
            const char* a3 = a2 + kstepA; const char* b3 = b2 + kstepB;
            if (last && has_next) S.a_ready(nxt);
            PG8_LDB(B0, 0, 0); PG8_LDB(B1, 0, 1); PG8_SCHED; PG8_LDA(At, 0, 0); PG8_STAGE(PG8_SA(1, 1), a1 + hstepA, voffA);
            PG8_WAIT_V(8); PG8_WAIT_L(0); PG8_BAR; PG8_MMA(0, 0, At, B0); PG8_MMA(0, 1, At, B1); PG8_BAR; PG8_SCHED;
            PG8_LDA(At, 0, 1); PG8_STAGE(PG8_SB(0, 0), b2, voffB); PG8_STAGE(PG8_SB(0, 1), b2 + hstepB, voffB); PG8_STAGE(PG8_SA(0, 0), a2, voffA);
            PG8_WAIT_V(8); PG8_WAIT_L(0); PG8_BAR; PG8_MMA(1, 0, At, B0); PG8_MMA(1, 1, At, B1); PG8_BAR; PG8_SCHED;
            PG8_LDB(B0, 1, 0); PG8_LDB(B1, 1, 1); PG8_SCHED; PG8_LDA(At, 1, 0); PG8_STAGE(PG8_SA(0, 1), a2 + hstepA, voffA);
            PG8_WAIT_V(8); PG8_WAIT_L(0); PG8_BAR; PG8_MMA(0, 0, At, B0); PG8_MMA(0, 1, At, B1); PG8_BAR; PG8_SCHED;
            PG8_LDA(At, 1, 1); PG8_STAGE(PG8_SB(1, 0), b3, voffB); PG8_STAGE(PG8_SB(1, 1), b3 + hstepB, voffB); PG8_STAGE(PG8_SA(1, 0), a3, voffA);
            PG8_WAIT_V(8); PG8_WAIT_L(0); PG8_BAR; PG8_MMA(1, 0, At, B0); PG8_MMA(1, 1, At, B1); PG8_BAR; PG8_SCHED;
        }
        if constexpr (ALIGN_EPI) { if (wr == 0) PG8_BAR; }
        E(acc, cur, wr, wc, fr, fq); S.done(cur);
        if (!has_next) break;
#pragma unroll
        for (int a = 0; a < 2; ++a)
#pragma unroll
            for (int b = 0; b < 2; ++b)
#pragma unroll
                for (int m = 0; m < 4; ++m)
#pragma unroll
                    for (int n = 0; n < 2; ++n) acc[a][b][m][n] = (acc_t){0, 0, 0, 0};
        cur = nxt; cA = nA; cB = nB; ++ui;
        if constexpr (ALIGN_EPI) { if (wr == 1) PG8_BAR; }
    }
    PG8_WAIT_V(0);
    if constexpr (!ALIGN_EPI) { if (wr == 0) PG8_BAR; }
    PG8_BAR;
#undef PG8_SA
#undef PG8_SB
#undef PG8_STAGE
#undef PG8_LDA
#undef PG8_LDB
#undef PG8_MMA
#undef PG8_WAIT_V
#undef PG8_WAIT_L
#undef PG8_BAR
#undef PG8_SCHED
#undef PG8_UA
#undef PG8_UB
}
}

constexpr int NWAVES = 8;
#ifndef MK_N_LAUNCHES
#define MK_N_LAUNCHES 1
#endif
constexpr int N_PHASES = 13;
#ifndef WGM_GU
#define WGM_GU 4
#endif
#ifndef BG_IN_P2
#define BG_IN_P2 1
#endif
#ifndef WD2_IN_P10
#define WD2_IN_P10 1
#endif
#ifndef FFN2_UP_IN_P0
#define FFN2_UP_IN_P0 1
#endif
#ifndef BG_TR
#define BG_TR 0
#endif
#ifndef NBG
#define NBG 0
#endif
#ifndef REV_DOWN
#define REV_DOWN 1
#endif
#ifndef WGM_DOWN
#define WGM_DOWN 4
#endif
#ifndef PROBE
#define PROBE 0
#endif
#ifndef PROBE_PH
#define PROBE_PH 0
#endif
constexpr int N_LAUNCHES = MK_N_LAUNCHES;
static_assert(N_LAUNCHES == 1 || N_LAUNCHES == N_PHASES, "MK_N_LAUNCHES is 1 or 13");

constexpr int M = 24576, M_PROMPT = 16384, SEQ_P = 8192, SEQ_S = 2048;
constexpr int D = 4096, FF = 11008, NGU = 2 * FF, DIN = 6144, DA = 2048, DB = 2048, NH = 16, HD = 128, CH = 128, DPG = 512;
constexpr float EPS = 1e-6f;

constexpr size_t MiB = 1u << 20;
constexpr size_t WS_CTL = 0, CTL_ZERO_BYTES = 64 * 1024;
constexpr size_t WS_STATS = 1 * MiB;
constexpr size_t WS_SA = 7 * MiB, WS_SW1 = 7 * MiB + 256 * 1024, WS_SW2 = 7 * MiB + 512 * 1024;
constexpr size_t WS_WGU1 = 8 * MiB, WS_WD1 = 94 * MiB, WS_WGU2 = 180 * MiB, WS_WD2 = 266 * MiB;
constexpr size_t WS_WIN = 352 * MiB, WS_WOUT = 400 * MiB, WS_WSP = 432 * MiB, WS_WPT = 433 * MiB;
constexpr size_t WS_A = 436 * MiB;
constexpr size_t WS_HID = 628 * MiB;
constexpr size_t WS_Z = WS_HID, WS_YCAT = WS_HID + 288 * MiB;
constexpr size_t WS_Y = 1144 * MiB;
constexpr size_t WS_END = 1336 * MiB;
static_assert((4096 + 3456) * 4 <= (int)CTL_ZERO_BYTES && WS_STATS + (size_t)M * 64 * 4 <= WS_SA && WS_SA + (size_t)M * 4 <= WS_SW1 && WS_SW1 + NGU * 4 <= WS_SW2 && WS_SW2 + NGU * 4 <= WS_WGU1, "ws map 0");
static_assert(WS_WGU1 + (size_t)NGU * D <= WS_WD1 && WS_WD1 + (size_t)D * FF * 2 <= WS_WGU2 && WS_WGU2 + (size_t)NGU * D <= WS_WD2 && WS_WD2 + (size_t)D * FF * 2 <= WS_WIN, "ws map 1");
static_assert(WS_WIN + (size_t)DIN * D * 2 <= WS_WOUT && WS_WOUT + (size_t)D * D * 2 <= WS_WSP && WS_WSP + (size_t)NH * CH * CH * 2 <= WS_WPT && WS_WPT + (size_t)DB * DPG * 2 <= WS_A, "ws map 2");
static_assert(WS_A + (size_t)M * D * 2 <= WS_HID && WS_HID + (size_t)M * FF * 2 <= WS_Y && WS_Y + (size_t)M * D * 2 <= WS_END && WS_YCAT + (size_t)M * D * 2 <= WS_Y && WS_Z + (size_t)M * DIN * 2 <= WS_YCAT, "ws map 3");
constexpr int CW_TMO = 0, CW_CODE = 1;
constexpr int CW_BAR = 4096, CW_BAR_END = CW_BAR + 3456;
constexpr int CW_PROBE = 512, CW_QUEUE = 640, CW_QUEUE2 = 704, CW_QUEUE3 = 768;

constexpr int RING_OFF = 0, RING_BYTES = 131072;
constexpr int LDSCTL_OFF = RING_BYTES, MISC_OFF = LDSCTL_OFF + 320;
constexpr int LDSX_OFF = LDSCTL_OFF + 1024;
constexpr int LDS_BYTES = 147456;
static_assert(MISC_OFF + 128 <= LDSX_OFF && LDSX_OFF + 4096 <= LDS_BYTES, "LDS map");

#define GAS __attribute__((address_space(1)))
#define LAS __attribute__((address_space(3)))
typedef unsigned short bf16;
typedef unsigned v4u __attribute__((ext_vector_type(4)));
typedef unsigned v2u __attribute__((ext_vector_type(2)));
typedef float f32x4 __attribute__((ext_vector_type(4)));
typedef short bf16x8 __attribute__((ext_vector_type(8)));
typedef GAS unsigned gu32;
#define RLX_AGENT __ATOMIC_RELAXED, __HIP_MEMORY_SCOPE_AGENT
#define LDS_WAIT() asm volatile("s_waitcnt lgkmcnt(0)" ::: "memory")
#define VM_WAIT() asm volatile("s_waitcnt vmcnt(0)" ::: "memory")
__device__ __forceinline__ unsigned f2bf(float f) { unsigned u = __builtin_bit_cast(unsigned, f); return (u + 0x7fffu + ((u >> 16) & 1u)) >> 16; }
__device__ __forceinline__ unsigned pk2(float lo, float hi) { return f2bf(lo) | (f2bf(hi) << 16); }
__device__ __forceinline__ float bf_lo(unsigned w) { return __builtin_bit_cast(float, w << 16); }
__device__ __forceinline__ float bf_hi(unsigned w) { return __builtin_bit_cast(float, w & 0xffff0000u); }
__device__ __forceinline__ unsigned q8(float v) { return (unsigned)(int)__builtin_rintf(v) & 255u; }
__device__ __forceinline__ unsigned pk4q(float a, float b, float c, float d) { return q8(a) | (q8(b) << 8) | (q8(c) << 16) | (q8(d) << 24); }

#define XB_TMO      128
#define XB_XCNT(j)  (256  + 64 * (j))
#define XB_XSUB(j)  (1280 + 64 * (j))
#define XB_XGEN(j)  (2304 + 64 * (j))
#define XB_TOP      3328
#define XB_TOPGEN   3392
#define XCD_BAR_WORDS 3456
#define XB_SPIN_CAP (1u << 18)

__device__ __forceinline__ unsigned xb_ld(unsigned* p)              { return __hip_atomic_load(p, __ATOMIC_RELAXED, __HIP_MEMORY_SCOPE_AGENT); }
__device__ __forceinline__ unsigned xb_add(unsigned* p, unsigned v) { return __hip_atomic_fetch_add(p, v, __ATOMIC_RELAXED, __HIP_MEMORY_SCOPE_AGENT); }
__device__ __forceinline__ unsigned xb_xcc_id() { return (unsigned)__builtin_amdgcn_s_getreg((3 << 11) | 20) & 0xFu; }
#define XB_SPIN(cond, bar) do { unsigned _sp = 0; while (cond) { __builtin_amdgcn_s_sleep(1); \
    if ((++_sp & 255u) == 0u) { if (xb_ld(&(bar)[XB_TMO])) break; if (_sp > XB_SPIN_CAP) { atomicAdd(&(bar)[XB_TMO], 1u); break; } } } } while (0)

struct XcdBarrier {
    unsigned* bar; unsigned x;
    volatile LAS unsigned* st;
};

__device__ __forceinline__ XcdBarrier xcd_barrier_post(unsigned* bar, volatile LAS unsigned* st) {
    XcdBarrier b; b.bar = bar; b.x = xb_xcc_id(); b.st = st;
    if (threadIdx.x == 0) (void)xb_add(&bar[XB_XCNT(b.x)], 1u);
    return b;
}
__device__ __forceinline__ void xcd_barrier_complete(unsigned* bar, unsigned x, unsigned& nloc, unsigned& nx) {
    const unsigned G = gridDim.x * gridDim.y * gridDim.z;
    unsigned sum, cnt, mine, sp = 0u;
    for (;;) {
        sum = 0u; cnt = 0u; mine = 0u;
#pragma unroll
        for (unsigned j = 0; j < 16; ++j) { const unsigned c = xb_ld(&bar[XB_XCNT(j)]); sum += c; cnt += (c > 0u) ? 1u : 0u; mine = (j == x) ? c : mine; }
        if (sum == G) break;
        __builtin_amdgcn_s_sleep(1);
        if ((++sp & 255u) == 0u) { if (xb_ld(&bar[XB_TMO])) break; if (sp > XB_SPIN_CAP) { atomicAdd(&bar[XB_TMO], 1u); break; } }
    }
    nloc = mine > 0u ? mine : 1u; nx = cnt > 0u ? cnt : 1u;
}

__device__ __forceinline__ void xcd_barrier(const XcdBarrier& b) {
    asm volatile("s_waitcnt vmcnt(0)" ::: "memory");
    __syncthreads();
    if (threadIdx.x == 0) {
        unsigned* bar = b.bar;
        __builtin_amdgcn_s_waitcnt(0);
        unsigned nloc = b.st[0], nx = b.st[1];
        if (nloc == 0u) { xcd_barrier_complete(bar, b.x, nloc, nx); b.st[0] = nloc; b.st[1] = nx; }
        const unsigned old = xb_add(&bar[XB_XSUB(b.x)], 1u);
        const unsigned gen = old / nloc;
        if (old + 1u == (gen + 1u) * nloc) {
            __builtin_amdgcn_fence(__ATOMIC_RELEASE, "agent");
            asm volatile("s_waitcnt vmcnt(0)" ::: "memory");
            const unsigned og = xb_add(&bar[XB_TOP], 1u);
            const unsigned tg = og / nx;
            if (og + 1u == (tg + 1u) * nx) xb_add(&bar[XB_TOPGEN], 1u);
            else XB_SPIN(xb_ld(&bar[XB_TOPGEN]) == tg, bar);
            __builtin_amdgcn_fence(__ATOMIC_ACQUIRE, "agent");
            xb_add(&bar[XB_XGEN(b.x)], 1u);
            asm volatile("s_waitcnt vmcnt(0)" ::: "memory");
        } else {
            XB_SPIN(xb_ld(&bar[XB_XGEN(b.x)]) == gen, bar);
            __builtin_amdgcn_fence(__ATOMIC_ACQUIRE, "agent");
            asm volatile("s_waitcnt vmcnt(0)" ::: "memory");
        }
    }
    __syncthreads();
}

struct Frame {
    LAS unsigned char* lds;
    volatile LAS unsigned* MISC;
    gu32* ctl;
    int tid, lane, wave;
    int vcu, G;
};

__device__ __forceinline__ float wave_sum(float v) {
#pragma unroll
    for (int o = 1; o < 64; o <<= 1) v += __shfl_xor(v, o);
    return v;
}
__device__ __forceinline__ float wave_max(float v) {
#pragma unroll
    for (int o = 1; o < 64; o <<= 1) v = fmaxf(v, __shfl_xor(v, o));
    return v;
}
template <bool TILED>
__device__ __forceinline__ void p0_transpose_item(const float* W, int K, int N, bf16* WT, int row_off, LAS float* scr, int item, int lane) {
    const int nblk = N / 32, kb = item / nblk, nb = item % nblk, k0 = 64 * kb, n0 = 32 * nb;
#pragma unroll 8
    for (int i = 0; i < 32; ++i) { const int kk = 2 * i + (lane >> 5); scr[kk * 33 + (lane & 31)] = W[(size_t)(k0 + kk) * N + n0 + (lane & 31)]; }
    LDS_WAIT(); asm volatile("" ::: "memory");
    const int c = lane & 7;
#pragma unroll
    for (int j = 0; j < 4; ++j) { const int n = (lane >> 3) + 8 * j; const LAS float* s = scr + (8 * c) * 33 + n;
        v4u o; o.x = pk2(s[0 * 33], s[1 * 33]); o.y = pk2(s[2 * 33], s[3 * 33]); o.z = pk2(s[4 * 33], s[5 * 33]); o.w = pk2(s[6 * 33], s[7 * 33]);
        if constexpr (TILED) { const int r = row_off + n0 + n;
            *(GAS v4u*)((GAS char*)WT + ((size_t)(r >> 8) * (K / 64) + kb) * 32768 + (r & 255) * 128 + 16 * c) = o; }
        else *(GAS v4u*)(WT + (size_t)(row_off + n0 + n) * K + k0 + 8 * c) = o; }
    LDS_WAIT(); asm volatile("" ::: "memory");
}
struct TJob { const float* W; bf16* WT; int K, N, row_off, tiled; const float* ks; };
__device__ __forceinline__ void tr_load(const TJob& J, int item, int lane, f32x4 (&v)[8]) {
    const int nblk = J.N / 32, kb = item / nblk, nb = item % nblk;
    const GAS f32x4* p = (const GAS f32x4*)(J.W + (size_t)(64 * kb + (lane >> 3)) * J.N + 32 * nb) + (lane & 7);
#pragma unroll
    for (int i = 0; i < 8; ++i) v[i] = __builtin_nontemporal_load(&p[(size_t)i * 8 * (J.N / 4)]);
    if (J.ks) {
        float s[8];
#pragma unroll
        for (int i = 0; i < 8; ++i) s[i] = J.ks[64 * kb + (lane >> 3) + 8 * i];
#pragma unroll
        for (int i = 0; i < 8; ++i) v[i] = v[i] * s[i];
    }
}
__device__ __forceinline__ void tr_commit(const TJob& J, int item, int lane, const f32x4 (&v)[8], LAS float* scr) {
    const int nblk = J.N / 32, kb = item / nblk, nb = item % nblk, k0 = 64 * kb, n0 = 32 * nb;
#pragma unroll
    for (int i = 0; i < 8; ++i) { LAS float* d = scr + (8 * i + (lane >> 3)) * 33 + 4 * (lane & 7); d[0] = v[i].x; d[1] = v[i].y; d[2] = v[i].z; d[3] = v[i].w; }
    LDS_WAIT(); asm volatile("" ::: "memory");
    const int c = lane & 7;
#pragma unroll
    for (int j = 0; j < 4; ++j) { const int n = (lane >> 3) + 8 * j; const LAS float* s = scr + (8 * c) * 33 + n;
        v4u o; o.x = pk2(s[0 * 33], s[1 * 33]); o.y = pk2(s[2 * 33], s[3 * 33]); o.z = pk2(s[4 * 33], s[5 * 33]); o.w = pk2(s[6 * 33], s[7 * 33]);
        const int r = J.row_off + n0 + n;
        if (J.tiled) __builtin_nontemporal_store(o, (GAS v4u*)((GAS char*)J.WT + ((size_t)(r >> 8) * (J.K / 64) + kb) * 32768 + (r & 255) * 128 + 16 * c));
        else __builtin_nontemporal_store(o, (GAS v4u*)(J.WT + (size_t)r * J.K + k0 + 8 * c)); }
    LDS_WAIT(); asm volatile("" ::: "memory");
}
__device__ __forceinline__ void p0_quant_item2(const float* W, float cm, signed char* WQ, int drow0, LAS float* scr, int kb, int n0, int lane) {
    const int k0 = 64 * kb;
#pragma unroll 8
    for (int i = 0; i < 32; ++i) { const int kk = 2 * i + (lane >> 5); scr[kk * 33 + (lane & 31)] = W[(size_t)(k0 + kk) * FF + n0 + (lane & 31)]; }
    LDS_WAIT(); asm volatile("" ::: "memory");
    const int c = lane & 3;
#pragma unroll
    for (int j = 0; j < 2; ++j) { const int n = (lane >> 2) + 16 * j; const LAS float* s = scr + (16 * c) * 33 + n;
        const float mxv = __shfl(cm, n); const float inv = mxv > 0.f ? 127.0f / mxv : 0.f;
        v4u o; o.x = pk4q(s[0 * 33] * inv, s[1 * 33] * inv, s[2 * 33] * inv, s[3 * 33] * inv); o.y = pk4q(s[4 * 33] * inv, s[5 * 33] * inv, s[6 * 33] * inv, s[7 * 33] * inv);
        o.z = pk4q(s[8 * 33] * inv, s[9 * 33] * inv, s[10 * 33] * inv, s[11 * 33] * inv); o.w = pk4q(s[12 * 33] * inv, s[13 * 33] * inv, s[14 * 33] * inv, s[15 * 33] * inv);
        *(GAS v4u*)(WQ + (size_t)(drow0 + n) * D + k0 + 16 * c) = o; }
    LDS_WAIT(); asm volatile("" ::: "memory");
}
__device__ __forceinline__ const float* x_row(const float* xp, const float* xs, int m) { return m < M_PROMPT ? xp + (size_t)m * D : xs + (size_t)(m - M_PROMPT) * D; }

__device__ __forceinline__ void quant_row_store(int lane, const f32x4 (&a)[16], signed char* qrow, float* sa) {
    float mx = 0.f;
#pragma unroll
    for (int j = 0; j < 16; ++j) mx = fmaxf(fmaxf(mx, fmaxf(fabsf(a[j].x), fabsf(a[j].y))), fmaxf(fabsf(a[j].z), fabsf(a[j].w)));
    mx = wave_max(mx);
    const float inv = mx > 0.f ? 127.0f / mx : 0.f;
    GAS unsigned* o = (GAS unsigned*)qrow + lane;
#pragma unroll
    for (int j = 0; j < 16; ++j) o[64 * j] = pk4q(a[j].x * inv, a[j].y * inv, a[j].z * inv, a[j].w * inv);
    if (lane == 0) *sa = mx > 0.f ? mx * (1.0f / 127.0f) : 1.0f;
}
__device__ __forceinline__ void rms_row_to_q(int lane, const float* xrow, const float* g, signed char* qrow, float* sa) {
    const GAS f32x4* xr = (const GAS f32x4*)xrow + lane; const GAS f32x4* gr = (const GAS f32x4*)g + lane;
    f32x4 v[16]; float s = 0.f;
#pragma unroll
    for (int j = 0; j < 16; ++j) v[j] = __builtin_nontemporal_load(&xr[64 * j]);
    __builtin_amdgcn_sched_barrier(0);
#pragma unroll
    for (int j = 0; j < 16; ++j) s += (v[j].x * v[j].x + v[j].y * v[j].y) + (v[j].z * v[j].z + v[j].w * v[j].w);
    const float r = 1.0f / sqrtf(wave_sum(s) * (1.f / D) + EPS);
#pragma unroll
    for (int j = 0; j < 16; ++j) v[j] = v[j] * r * gr[64 * j];
    quant_row_store(lane, v, qrow, sa);
}

template <int MODE, bool BASE_X, int DIR>
__device__ __forceinline__ void norm_phase(Frame& F, const float* baseP, const float* baseS, const bf16* Y, const float* stats, float c, const float* gpost, const float* g2, float* OUT, bf16* A, signed char* AQ, float* SA) {
    LAS f32x4* gl = (LAS f32x4*)(F.lds + RING_OFF);
    for (int i = F.tid; i < D / 4; i += NWAVES * 64) { gl[i] = ((const GAS f32x4*)gpost)[i]; gl[1024 + i] = ((const GAS f32x4*)g2)[i]; }
    LDS_WAIT(); __syncthreads();
    const int lane = F.lane, nx = (F.G % 8 == 0) ? 8 : 1, gpx = F.G / nx, MX = M / nx, wpx = gpx * NWAVES, xq = F.vcu / gpx, j0 = (F.vcu % gpx) * NWAVES + F.wave;
    for (int j = j0; j < MX; j += wpx) {
        const int m = xq * MX + (DIR ? MX - 1 - j : j);
        const GAS f32x4* br = (const GAS f32x4*)x_row(baseP, baseS, m) + lane;
        GAS v2u* hb = (GAS v2u*)((bf16*)(OUT + (size_t)m * D) + D) + lane;
        const GAS v2u* yr = (const GAS v2u*)(Y + (size_t)m * D) + lane;
        const float ssy = wave_sum(stats[(size_t)m * 64 + lane]);
        const float ry = c / sqrtf(ssy * (1.f / D) + EPS);
        constexpr int NB = (PROBE != 0) ? 8 : 16;
        f32x4 h[16]; v2u yv[NB], bv[BASE_X ? 1 : NB]; float s = 0.f;
#pragma unroll
        for (int jb = 0; jb < 16; jb += NB) {
#pragma unroll
            for (int j = 0; j < NB; ++j) { if constexpr (BASE_X) h[jb + j] = br[64 * (jb + j)]; else bv[j] = hb[64 * (jb + j)];
                yv[j] = yr[64 * (jb + j)]; }
            __builtin_amdgcn_sched_barrier(0);
#pragma unroll
            for (int j = 0; j < NB; ++j) { f32x4 b; if constexpr (BASE_X) b = h[jb + j]; else { const v2u bb = bv[j]; b.x = bf_lo(bb.x); b.y = bf_hi(bb.x); b.z = bf_lo(bb.y); b.w = bf_hi(bb.y); }
                const v2u yy = yv[j]; const f32x4 gp = gl[64 * (jb + j) + lane];
                f32x4 y; y.x = bf_lo(yy.x); y.y = bf_hi(yy.x); y.z = bf_lo(yy.y); y.w = bf_hi(yy.y);
                h[jb + j] = b + y * ry * gp; s += (h[jb + j].x * h[jb + j].x + h[jb + j].y * h[jb + j].y) + (h[jb + j].z * h[jb + j].z + h[jb + j].w * h[jb + j].w); }
            if (NB < 16) __builtin_amdgcn_sched_barrier(0);
        }
        const float rh = 1.0f / sqrtf(wave_sum(s) * (1.f / D) + EPS);
        if constexpr (MODE == 1) {
            GAS f32x4* ho = (GAS f32x4*)(OUT + (size_t)m * D) + lane;
#pragma unroll
            for (int j = 0; j < 16; ++j) { const f32x4 gg = gl[1024 + 64 * j + lane]; ho[64 * j] = h[j] * rh * gg; }
        } else if constexpr (MODE == 0) {
#pragma unroll
            for (int j = 0; j < 16; ++j) { v2u hw; hw.x = pk2(h[j].x, h[j].y); hw.y = pk2(h[j].z, h[j].w); hb[64 * j] = hw; }
            if (lane == 0) SA[m] = rh;
        } else {
#pragma unroll
            for (int j = 0; j < 16; ++j) { const f32x4 gg = gl[1024 + 64 * j + lane]; v2u hw; hw.x = pk2(h[j].x, h[j].y); hw.y = pk2(h[j].z, h[j].w); hb[64 * j] = hw; h[j] = h[j] * rh * gg; }
            quant_row_store(lane, h, AQ + (size_t)m * D, SA + m);
        }
    }
}

__device__ __forceinline__ void spatial_units(Frame& F, int u0, int u1, const bf16* Z, const bf16* WSP, const float* b_sp, const float* v_norm, bf16* YCAT) {
    constexpr int VS = 136, VBUF = 128 * VS * 2;
    const int tid = F.tid, s = tid >> 2, q = tid & 3, w = F.wave, fr = F.lane & 15, fq = F.lane >> 4, t = 16 * w + fr;
    if (u0 >= u1) return;
    v4u vw[4];
    { const GAS v4u* src = (const GAS v4u*)(Z + (size_t)((u0 / NH) * CH + s) * DIN + DA + (u0 % NH) * HD + q * 32);
#pragma unroll
      for (int i = 0; i < 4; ++i) vw[i] = src[i]; }
    for (int ui = u0; ui < u1; ++ui) {
        const int cidx = ui / NH, h = ui % NH, r0 = cidx * CH;
        LAS bf16* vT = (LAS bf16*)(F.lds + RING_OFF + ((ui - u0) & 1) * VBUF);
        bf16x8 af[4];
#pragma unroll
        for (int kk = 0; kk < 4; ++kk) af[kk] = *(const GAS bf16x8*)(WSP + (size_t)h * CH * CH + t * CH + kk * 32 + fq * 8);
        const GAS v4u* ur = (const GAS v4u*)(Z + (size_t)(r0 + t) * DIN + h * HD + 8 * fq);
        v4u uu[4];
#pragma unroll
        for (int p = 0; p < 4; ++p) uu[p] = ur[4 * p];
        const float bias = b_sp[h * CH + t];
        {   float v[32]; float ss = 0.f;
#pragma unroll
            for (int i = 0; i < 4; ++i) { v[8 * i + 0] = bf_lo(vw[i].x); v[8 * i + 1] = bf_hi(vw[i].x); v[8 * i + 2] = bf_lo(vw[i].y); v[8 * i + 3] = bf_hi(vw[i].y);
                v[8 * i + 4] = bf_lo(vw[i].z); v[8 * i + 5] = bf_hi(vw[i].z); v[8 * i + 6] = bf_lo(vw[i].w); v[8 * i + 7] = bf_hi(vw[i].w); }
#pragma unroll
            for (int j = 0; j < 32; ++j) ss += v[j] * v[j];
            ss += __shfl_xor(ss, 1); ss += __shfl_xor(ss, 2);
            const float r = 1.0f / sqrtf(ss * (1.f / HD) + EPS);
            const GAS f32x4* vn = (const GAS f32x4*)(v_norm + h * HD + q * 32);
#pragma unroll
            for (int j4 = 0; j4 < 8; ++j4) { const f32x4 gn = vn[j4];
                vT[(q * 32 + 4 * j4 + 0) * VS + s] = (bf16)f2bf(v[4 * j4 + 0] * r * gn.x); vT[(q * 32 + 4 * j4 + 1) * VS + s] = (bf16)f2bf(v[4 * j4 + 1] * r * gn.y);
                vT[(q * 32 + 4 * j4 + 2) * VS + s] = (bf16)f2bf(v[4 * j4 + 2] * r * gn.z); vT[(q * 32 + 4 * j4 + 3) * VS + s] = (bf16)f2bf(v[4 * j4 + 3] * r * gn.w); }
        }
        LDS_WAIT(); __syncthreads();
        if (ui + 1 < u1) { const int un = ui + 1; const GAS v4u* src = (const GAS v4u*)(Z + (size_t)((un / NH) * CH + s) * DIN + DA + (un % NH) * HD + q * 32);
#pragma unroll
            for (int i = 0; i < 4; ++i) vw[i] = src[i]; }
        f32x4 acc[8];
#pragma unroll
        for (int n = 0; n < 8; ++n) { acc[n] = (f32x4){0.f, 0.f, 0.f, 0.f};
#pragma unroll
            for (int kk = 0; kk < 4; ++kk) { const bf16x8 bfr = *(const LAS bf16x8*)(vT + (32 * (n >> 1) + 8 * (fr >> 2) + 4 * (n & 1) + (fr & 3)) * VS + kk * 32 + fq * 8);
                acc[n] = __builtin_amdgcn_mfma_f32_16x16x32_bf16(bfr, af[kk], acc[n], 0, 0, 0); } }
        GAS v4u* orow = (GAS v4u*)(YCAT + (size_t)(r0 + t) * D + h * HD + 8 * fq);
#pragma unroll
        for (int p = 0; p < 4; ++p) { const v4u w = uu[p]; const f32x4 a0 = acc[2 * p], a1 = acc[2 * p + 1];
            v4u o; o.x = pk2(bf_lo(w.x) * (a0[0] + bias), bf_hi(w.x) * (a0[1] + bias)); o.y = pk2(bf_lo(w.y) * (a0[2] + bias), bf_hi(w.y) * (a0[3] + bias));
            o.z = pk2(bf_lo(w.z) * (a1[0] + bias), bf_hi(w.z) * (a1[1] + bias)); o.w = pk2(bf_lo(w.w) * (a1[2] + bias), bf_hi(w.w) * (a1[3] + bias));
            orow[4 * p] = o; }
    }
    LDS_WAIT(); __syncthreads();
}

__device__ __forceinline__ void acc8(float (&S)[8], const v4u w, float sgn) {
    S[0] += sgn * bf_lo(w.x); S[1] += sgn * bf_hi(w.x); S[2] += sgn * bf_lo(w.y); S[3] += sgn * bf_hi(w.y); S[4] += sgn * bf_lo(w.z); S[5] += sgn * bf_hi(w.z); S[6] += sgn * bf_lo(w.w); S[7] += sgn * bf_hi(w.w); }
template <int HW>
__device__ __forceinline__ void pool_strip8(const bf16* Z, bf16* PB, int strip, int cg) {
    const int m0 = strip * 8;
    const int s0 = (m0 < M_PROMPT) ? (m0 & ~(SEQ_P - 1)) : (M_PROMPT + ((m0 - M_PROMPT) & ~(SEQ_S - 1)));
    const int len = (m0 < M_PROMPT) ? SEQ_P : SEQ_S, t0 = m0 - s0;
    const bf16* zc = Z + (size_t)s0 * DIN + 2 * DA + 8 * cg;
    constexpr int NR = 2 * HW + 7;
    v4u r[NR];
#pragma unroll
    for (int j = 0; j < NR; ++j) { const int t = t0 - HW + j; r[j] = (v4u){0u, 0u, 0u, 0u}; if (t >= 0 && t < len) r[j] = *(const GAS v4u*)(zc + (size_t)t * DIN); }
    float S[8];
#pragma unroll
    for (int i = 0; i < 8; ++i) S[i] = 0.f;
#pragma unroll
    for (int j = 0; j < 2 * HW; ++j) acc8(S, r[j], 1.0f);
#pragma unroll
    for (int i = 0; i < 8; ++i) { const int t = t0 + i;
        const int lo = (t - HW) > 0 ? (t - HW) : 0, hi = (t + HW) < len ? (t + HW) : len;
        const float inv = 1.0f / (float)(hi - lo); const v4u w = r[i + HW];
        v4u o; o.x = pk2(S[0] * inv - bf_lo(w.x), S[1] * inv - bf_hi(w.x)); o.y = pk2(S[2] * inv - bf_lo(w.y), S[3] * inv - bf_hi(w.y));
        o.z = pk2(S[4] * inv - bf_lo(w.z), S[5] * inv - bf_hi(w.z)); o.w = pk2(S[6] * inv - bf_lo(w.w), S[7] * inv - bf_hi(w.w));
        *(GAS v4u*)(PB + (size_t)(s0 + t) * DB + 8 * cg) = o;
        if (i < 7) { acc8(S, r[i + 2 * HW], 1.0f); acc8(S, r[i], -1.0f); } }
}

struct Args { const float* in[22]; float* out; unsigned char* ws; int ph_lo, ph_hi; };
__global__ void __launch_bounds__(NWAVES * 64, 2) mk_fwd(Args args) {
    extern __shared__ __attribute__((aligned(16))) unsigned char lds[];
    Frame F;
    F.lds = (LAS unsigned char*)lds;
    F.MISC = (volatile LAS unsigned*)(F.lds + MISC_OFF);
    F.tid = threadIdx.x; F.lane = F.tid & 63; F.wave = __builtin_amdgcn_readfirstlane(F.tid >> 6);
    F.G = gridDim.x; { const int bx = blockIdx.x; F.vcu = (F.G % 8 == 0) ? (bx % 8) * (F.G / 8) + bx / 8 : bx; }
    unsigned char* ws = args.ws;
    F.ctl = (gu32*)(ws + WS_CTL);
    for (int u = F.tid; u < (LDS_BYTES - LDSCTL_OFF) / 4; u += NWAVES * 64) ((LAS unsigned*)(F.lds + LDSCTL_OFF))[u] = 0u;
    __syncthreads();
    XcdBarrier bar; bar.bar = (unsigned*)(F.ctl + CW_BAR); bar.x = 0; bar.st = nullptr;
    if (N_LAUNCHES == 1) bar = xcd_barrier_post((unsigned*)(F.ctl + CW_BAR), F.MISC + 8);
    volatile LAS unsigned long long* pr = (volatile LAS unsigned long long*)(F.lds + LDSX_OFF + 3072);
    if (PROBE != 0 && F.tid == 0) { pr[0] = 0ull; pr[1] = 0ull; pr[2] = __builtin_amdgcn_s_memrealtime(); }
#define PR_SET() do { if (F.tid == 0) pr[0] = __builtin_amdgcn_s_memrealtime(); } while (0)
#define PR_DIFF() do { if (F.tid == 0) pr[0] = __builtin_amdgcn_s_memrealtime() - pr[0]; } while (0)
    int pr_seam = 0;
#define GRID_BAR() do { if (N_LAUNCHES == 1) { const bool _m = (PROBE == 6) || (PROBE == 12 && pr_seam == PROBE_PH); if (_m && F.tid == 0) pr[3] = __builtin_amdgcn_s_memrealtime(); xcd_barrier(bar); if (_m && F.tid == 0) pr[1] += __builtin_amdgcn_s_memrealtime() - pr[3]; ++pr_seam; } } while (0)

    const float* x_p = args.in[0]; const float* x_s = args.in[1];
    signed char* WGU1 = (signed char*)(ws + WS_WGU1); bf16* WD1 = (bf16*)(ws + WS_WD1); signed char* WGU2 = (signed char*)(ws + WS_WGU2); bf16* WD2 = (bf16*)(ws + WS_WD2);
    bf16* WIN = (bf16*)(ws + WS_WIN); bf16* WOUT = (bf16*)(ws + WS_WOUT); bf16* WSP = (bf16*)(ws + WS_WSP); bf16* WPT = (bf16*)(ws + WS_WPT);
    bf16* AB = (bf16*)(ws + WS_A); signed char* AQ = (signed char*)(ws + WS_A); bf16* PB = (bf16*)(ws + WS_A);
    bf16* HID = (bf16*)(ws + WS_HID); bf16* ZB = (bf16*)(ws + WS_Z); bf16* YCAT = (bf16*)(ws + WS_YCAT); bf16* YB = (bf16*)(ws + WS_Y);
    float* STATS = (float*)(ws + WS_STATS); float* SA = (float*)(ws + WS_SA); float* SW1 = (float*)(ws + WS_SW1); float* SW2 = (float*)(ws + WS_SW2);
    float* H = args.out;

    const int lo = args.ph_lo, hi = args.ph_hi;
#define IN(k) (lo <= (k) && (k) < hi)
#define BOTH(k) (IN(k) && IN((k) == 0 ? 2 : (k) + 1))

    LAS float* const scr = (LAS float*)(F.lds + RING_OFF + F.wave * 16384);
    LAS float* const cmx = (LAS float*)(F.lds + LDSX_OFF);
    volatile LAS unsigned* const tkt = (volatile LAS unsigned*)(F.lds + LDSX_OFF + 2048);
    const int lane = F.lane;
    constexpr int NCBLK = FF / 32;
    auto gu_job = [&](const int mat, const int n0, const int jpar) __attribute__((always_inline)) {
            const float* W = args.in[mat == 0 ? 4 : mat == 1 ? 5 : mat == 2 ? 18 : 19];
            const int c4 = lane & 7, krow0 = F.wave * 512 + (lane >> 3) * 64;
            const GAS f32x4* p = (const GAS f32x4*)(W + (size_t)krow0 * FF + n0) + c4;
            v2u d[64]; float m0 = 0.f, m1 = 0.f, m2 = 0.f, m3 = 0.f;
#pragma unroll
            for (int ib = 0; ib < 4; ++ib) {
                f32x4 v[16];
#pragma unroll
                for (int i = 0; i < 16; ++i) v[i] = __builtin_nontemporal_load(&p[(size_t)(16 * ib + i) * (FF / 4)]);
                __builtin_amdgcn_sched_barrier(0);
#pragma unroll
                for (int i = 0; i < 16; ++i) { m0 = fmaxf(m0, fabsf(v[i].x)); m1 = fmaxf(m1, fabsf(v[i].y)); m2 = fmaxf(m2, fabsf(v[i].z)); m3 = fmaxf(m3, fabsf(v[i].w));
                    d[16 * ib + i].x = pg8::cvt_pk_bf16(v[i].x, v[i].y); d[16 * ib + i].y = pg8::cvt_pk_bf16(v[i].z, v[i].w); }
                __builtin_amdgcn_sched_barrier(0);
            }
#pragma unroll
            for (int o = 8; o < 64; o <<= 1) { m0 = fmaxf(m0, __shfl_xor(m0, o)); m1 = fmaxf(m1, __shfl_xor(m1, o)); m2 = fmaxf(m2, __shfl_xor(m2, o)); m3 = fmaxf(m3, __shfl_xor(m3, o)); }
            if (lane < 8) { LAS float* cw = cmx + (jpar * 8 + F.wave) * 32 + 4 * lane; cw[0] = m0; cw[1] = m1; cw[2] = m2; cw[3] = m3; }
            LDS_WAIT(); __syncthreads();
            f32x4 cm4 = (f32x4){0.f, 0.f, 0.f, 0.f};
#pragma unroll
            for (int w8 = 0; w8 < 8; ++w8) { const f32x4 cv = *(const LAS f32x4*)(cmx + (jpar * 8 + w8) * 32 + 4 * c4); cm4.x = fmaxf(cm4.x, cv.x); cm4.y = fmaxf(cm4.y, cv.y); cm4.z = fmaxf(cm4.z, cv.z); cm4.w = fmaxf(cm4.w, cv.w); }
            const float i0 = cm4.x > 0.f ? 127.0f / cm4.x : 0.f, i1 = cm4.y > 0.f ? 127.0f / cm4.y : 0.f, i2 = cm4.z > 0.f ? 127.0f / cm4.z : 0.f, i3 = cm4.w > 0.f ? 127.0f / cm4.w : 0.f;
            const int drow0 = 256 * (n0 >> 7) + (n0 & 127) + ((mat & 1) ? 128 : 0);
            signed char* WQ = mat < 2 ? WGU1 : WGU2;
            GAS char* q0p = (GAS char*)WQ + (size_t)(drow0 + 4 * c4) * D + krow0;
#pragma unroll
            for (int b = 0; b < 4; ++b) {
                v4u o0, o1, o2, o3;
#pragma unroll
                for (int a = 0; a < 4; ++a) { const v2u r0 = d[16 * b + 4 * a + 0], r1 = d[16 * b + 4 * a + 1], r2 = d[16 * b + 4 * a + 2], r3 = d[16 * b + 4 * a + 3];
                    o0[a] = pk4q(bf_lo(r0.x) * i0, bf_lo(r1.x) * i0, bf_lo(r2.x) * i0, bf_lo(r3.x) * i0); o1[a] = pk4q(bf_hi(r0.x) * i1, bf_hi(r1.x) * i1, bf_hi(r2.x) * i1, bf_hi(r3.x) * i1);
                    o2[a] = pk4q(bf_lo(r0.y) * i2, bf_lo(r1.y) * i2, bf_lo(r2.y) * i2, bf_lo(r3.y) * i2); o3[a] = pk4q(bf_hi(r0.y) * i3, bf_hi(r1.y) * i3, bf_hi(r2.y) * i3, bf_hi(r3.y) * i3); }
                *(GAS v4u*)(q0p + 0 * D + 16 * b) = o0; *(GAS v4u*)(q0p + 1 * D + 16 * b) = o1; *(GAS v4u*)(q0p + 2 * D + 16 * b) = o2; *(GAS v4u*)(q0p + 3 * D + 16 * b) = o3; }
            if (F.wave == 0 && lane < 8) { float* swp = (mat < 2 ? SW1 : SW2) + drow0 + 4 * c4;
                swp[0] = cm4.x > 0.f ? cm4.x * (1.0f / 127.0f) : 1.0f; swp[1] = cm4.y > 0.f ? cm4.y * (1.0f / 127.0f) : 1.0f; swp[2] = cm4.z > 0.f ? cm4.z * (1.0f / 127.0f) : 1.0f; swp[3] = cm4.w > 0.f ? cm4.w * (1.0f / 127.0f) : 1.0f; }
    };
    constexpr int I_D = (FF / 64) * (D / 32), I_IN = (D / 64) * (DIN / 32), I_OUT = (D / 64) * (D / 32), I_P = (DPG / 64) * (DPG / 32);
    constexpr int NITEMS = 2 * I_D + I_IN + I_OUT + 4 * I_P, NCT = NITEMS / 32, NCX = M / 32;
    constexpr int NC_D2 = I_D / 32;
    static_assert(I_D % 32 == 0 && !(WD2_IN_P10 && BG_TR), "WD2 chunks");
    static_assert(NITEMS % 32 == 0 && M % 32 == 0 && I_D % 4 == 0 && I_IN % 4 == 0 && I_OUT % 4 == 0 && I_P % 4 == 0, "queue chunks");
    auto tr_chunk = [&](const int cur) __attribute__((always_inline)) {
        int r = (cur * 8 + F.wave) * 4;
        TJob J;
        if (r < I_D) J = TJob{args.in[6], WD1, FF, D, 0, 1, nullptr};
        else if ((r -= I_D) < I_IN) J = TJob{args.in[9], WIN, D, DIN, 0, 0, args.in[7]};
        else if ((r -= I_IN) < I_OUT) J = TJob{args.in[15], WOUT, D, D, 0, 0, nullptr};
        else if ((r -= I_OUT) < 4 * I_P) { const int gp = r / I_P; J = TJob{args.in[13] + (size_t)gp * DPG * DPG, WPT, DPG, DPG, gp * DPG, 0, nullptr}; r -= gp * I_P; }
        else { r -= 4 * I_P; J = TJob{args.in[20], WD2, FF, D, 0, 1, nullptr}; }
#pragma unroll
        for (int i = 0; i < 4; i += 2) { f32x4 va[8], vb[8];
            tr_load(J, r + i, lane, va); tr_load(J, r + i + 1, lane, vb);
            __builtin_amdgcn_sched_barrier(0);
            tr_commit(J, r + i, lane, va, scr); tr_commit(J, r + i + 1, lane, vb, scr); }
    };
    if (IN(0)) { if (PROBE == 11 && PROBE_PH == 0) PR_SET();
        constexpr int NJOBS = (BG_IN_P2 ? (FFN2_UP_IN_P0 ? 3 : 2) : 4) * NCBLK;
        int jpar = 0;
        for (int job = F.vcu; job < NJOBS; job += F.G, jpar ^= 1) { const int mj = job / NCBLK; gu_job((BG_IN_P2 && mj == 2) ? 3 : mj, (job % NCBLK) * 32, jpar); }
        for (int i = (blockIdx.x * NWAVES * 64 + F.tid); i < NH * CH * CH / 4; i += F.G * NWAVES * 64) {
            const f32x4 v = ((const GAS f32x4*)args.in[10])[i]; v2u w; w.x = pk2(v.x, v.y); w.y = pk2(v.z, v.w); ((GAS v2u*)WSP)[i] = w; }
        constexpr int NT0 = (BG_IN_P2 && BG_TR) ? 0 : NCT - (WD2_IN_P10 ? NC_D2 : 0), NCHUNK = NT0 + NCX;
        unsigned* qhead = (unsigned*)(F.ctl + CW_QUEUE);
        unsigned nxt = 0u; int tpar = 0;
        if (F.tid == 0) nxt = __hip_atomic_fetch_add(qhead, 1u, RLX_AGENT);
        for (;;) {
            if (F.tid == 0) tkt[tpar] = nxt;
            LDS_WAIT(); __syncthreads();
            const unsigned cur = tkt[tpar]; tpar ^= 1;
            if (cur >= (unsigned)NCHUNK) break;
            if (F.tid == 0) nxt = __hip_atomic_fetch_add(qhead, 1u, RLX_AGENT);
            if (cur < (unsigned)NT0) tr_chunk((int)cur);
            else { for (int i = 0; i < 4; ++i) { const int m = (((int)cur - NT0) * 8 + F.wave) * 4 + i; rms_row_to_q(lane, x_row(x_p, x_s, m), args.in[2], AQ + (size_t)m * D, SA + m); } }
        }
        if (BOTH(0)) GRID_BAR();
        if (PROBE == 11 && PROBE_PH == 0) PR_DIFF();
        if (PROBE == 9) do { if (F.tid == 0) pr[0] = __builtin_amdgcn_s_memrealtime() - pr[2]; } while (0);
    }
    if (IN(2)) { if (PROBE == 11 && PROBE_PH == 2) PR_SET();
        const int GG = BG_IN_P2 ? F.G - NBG : F.G;
        if ((int)blockIdx.x < GG) {
            pg8::Gemm g = pg8::gemm_rm(AQ, WGU1, D, D, D); pg8::StaticOrder S; S.init(M, NGU, GG, (int)blockIdx.x, WGM_GU);
            pg8::EpiSwiGLUQ E{HID, FF, SA, SW1};
            pg8::gemm_phase<pg8::EpiSwiGLUQ, pg8::StaticOrder, true>(F.lds + RING_OFF, g, S, E);
        }
        if (BG_IN_P2) {
            constexpr int NJ2 = (FFN2_UP_IN_P0 ? 1 : 2) * NCBLK, NTK = NJ2 + (BG_TR ? NCT : 0);
            unsigned* qhead = (unsigned*)(F.ctl + CW_QUEUE2);
            unsigned nxt = 0u; int tpar = 0, jpar = 0;
            if (F.tid == 0) nxt = __hip_atomic_fetch_add(qhead, 1u, RLX_AGENT);
            for (;;) {
                if (F.tid == 0) tkt[tpar] = nxt;
                LDS_WAIT(); __syncthreads();
                const unsigned cur = tkt[tpar]; tpar ^= 1;
                if (cur >= (unsigned)NTK) break;
                if (F.tid == 0) nxt = __hip_atomic_fetch_add(qhead, 1u, RLX_AGENT);
                if (cur < (unsigned)NJ2) { gu_job(2 + (int)cur / NCBLK, ((int)cur % NCBLK) * 32, jpar); jpar ^= 1; }
                else tr_chunk((int)cur - NJ2);
            }
        }
        if (BOTH(2)) GRID_BAR();
        if (PROBE == 11 && PROBE_PH == 2) PR_DIFF();
    }
    if (IN(3)) { if (PROBE == 11 && PROBE_PH == 3) PR_SET();
        pg8::Gemm g = pg8::gemm_tiled(HID, WD1, FF * 2); pg8::StaticOrder S; S.init(M, D, F.G, (int)blockIdx.x, WGM_DOWN, REV_DOWN);
        pg8::EpiYStats E{YB, D, STATS};
        pg8::gemm_phase<pg8::EpiYStats, pg8::StaticOrder, true>(F.lds + RING_OFF, g, S, E);
        if (BOTH(3)) GRID_BAR();
        if (PROBE == 11 && PROBE_PH == 3) PR_DIFF();
    }
    if (IN(4)) { if (PROBE == 11 && PROBE_PH == 4) PR_SET();
        norm_phase<0, true, 0>(F, x_p, x_s, YB, STATS, 0.5f, args.in[3], args.in[7], H, nullptr, nullptr, SA);
        if (BOTH(4)) GRID_BAR();
        if (PROBE == 11 && PROBE_PH == 4) PR_DIFF();
    }
    if (IN(5)) { if (PROBE == 11 && PROBE_PH == 5) PR_SET();
        pg8::Gemm g = pg8::gemm_rm((const char*)H + D * 2, WIN, D * 4, D * 2, D * 2);   pg8::MixOrder S; S.init(M, DIN, F.G, (int)blockIdx.x, 4, 1);
        pg8::EpiZ E{ZB, DIN, (2 * DA) / 256, SA};
        pg8::gemm_phase<pg8::EpiZ, pg8::MixOrder, true>(F.lds + RING_OFF, g, S, E);
        if (BOTH(5)) GRID_BAR();
        if (PROBE == 11 && PROBE_PH == 5) PR_DIFF();
    }
    if (IN(6)) { if (PROBE == 11 && PROBE_PH == 6) PR_SET();
        constexpr int NUNITS = (M / CH) * NH;
        const int per = (NUNITS + F.G - 1) / F.G;
        { const int ua = F.vcu * per, ub = (ua + per) < NUNITS ? (ua + per) : NUNITS; spatial_units(F, ua, ub, ZB, WSP, args.in[11], args.in[12], YCAT); }
        constexpr int NSTRIPS = M / 8;
        for (int sp = F.vcu * 2 + (F.tid >> 8); sp < NSTRIPS; sp += F.G * 2) { const int cg = F.tid & 255;
            switch (cg >> 6) { case 0: pool_strip8<1>(ZB, PB, sp, cg); break; case 1: pool_strip8<2>(ZB, PB, sp, cg); break; case 2: pool_strip8<4>(ZB, PB, sp, cg); break; default: pool_strip8<8>(ZB, PB, sp, cg); break; } }
        if (BOTH(6)) GRID_BAR();
        if (PROBE == 11 && PROBE_PH == 6) PR_DIFF();
    }
    if (IN(7)) { if (PROBE == 11 && PROBE_PH == 7) PR_SET();
        pg8::Gemm g = pg8::gemm_rm(PB, WPT, DB * 2, DPG * 2, DPG * 2, DPG * 2); pg8::StaticOrder S; S.init(M, DB, F.G, (int)blockIdx.x);
        pg8::EpiScale E{YCAT, D, DA, args.in[14]};
        pg8::gemm_phase<pg8::EpiScale, pg8::StaticOrder, true>(F.lds + RING_OFF, g, S, E);
        if (BOTH(7)) GRID_BAR();
        if (PROBE == 11 && PROBE_PH == 7) PR_DIFF();
    }
    if (IN(8)) { if (PROBE == 11 && PROBE_PH == 8) PR_SET();
        pg8::Gemm g = pg8::gemm_rm(YCAT, WOUT, D * 2, D * 2, D * 2); pg8::StaticOrder S; S.init(M, D, F.G, (int)blockIdx.x, 4);
        pg8::EpiYStats E{YB, D, STATS};
        pg8::gemm_phase<pg8::EpiYStats, pg8::StaticOrder, true>(F.lds + RING_OFF, g, S, E);
        if (BOTH(8)) GRID_BAR();
        if (PROBE == 11 && PROBE_PH == 8) PR_DIFF();
    }
    if (IN(9)) { if (PROBE == 11 && PROBE_PH == 9) PR_SET();
        norm_phase<2, false, 1>(F, nullptr, nullptr, YB, STATS, 1.0f, args.in[8], args.in[16], H, nullptr, AQ, SA);
        if (BOTH(9)) GRID_BAR();
        if (PROBE == 11 && PROBE_PH == 9) PR_DIFF();
    }
    if (IN(10)) { if (PROBE == 11 && PROBE_PH == 10) PR_SET();
        pg8::Gemm g = pg8::gemm_rm(AQ, WGU2, D, D, D); pg8::StaticOrder S; S.init(M, NGU, F.G, (int)blockIdx.x, WGM_GU);
        pg8::EpiSwiGLUQ E{HID, FF, SA, SW2};
        pg8::gemm_phase<pg8::EpiSwiGLUQ, pg8::StaticOrder, true>(F.lds + RING_OFF, g, S, E);
        if (WD2_IN_P10) {
            unsigned* qhead = (unsigned*)(F.ctl + CW_QUEUE3);
            unsigned nxt = 0u; int tpar = 0;
            if (F.tid == 0) nxt = __hip_atomic_fetch_add(qhead, 1u, RLX_AGENT);
            for (;;) {
                if (F.tid == 0) tkt[tpar] = nxt;
                LDS_WAIT(); __syncthreads();
                const unsigned cur = tkt[tpar]; tpar ^= 1;
                if (cur >= (unsigned)NC_D2) break;
                if (F.tid == 0) nxt = __hip_atomic_fetch_add(qhead, 1u, RLX_AGENT);
                tr_chunk(NCT - NC_D2 + (int)cur);
            }
        }
        if (BOTH(10)) GRID_BAR();
        if (PROBE == 11 && PROBE_PH == 10) PR_DIFF();
    }
    if (IN(11)) { if (PROBE == 11 && PROBE_PH == 11) PR_SET();
        pg8::Gemm g = pg8::gemm_tiled(HID, WD2, FF * 2); pg8::StaticOrder S; S.init(M, D, F.G, (int)blockIdx.x, WGM_DOWN, REV_DOWN);
        pg8::EpiYStats E{YB, D, STATS};
        pg8::gemm_phase<pg8::EpiYStats, pg8::StaticOrder, true>(F.lds + RING_OFF, g, S, E);
        if (BOTH(11)) GRID_BAR();
        if (PROBE == 11 && PROBE_PH == 11) PR_DIFF();
    }
    if (IN(12)) { if (PROBE == 11 && PROBE_PH == 12) PR_SET();
        norm_phase<1, false, 0>(F, nullptr, nullptr, YB, STATS, 0.5f, args.in[17], args.in[21], H, nullptr, nullptr, nullptr);
    }
    if (PROBE == 9 || PROBE == 10 || PROBE == 11) {
        GRID_BAR();
        if (blockIdx.x == 0 && F.tid == 0) { const unsigned long long t0 = __builtin_amdgcn_s_memrealtime(); const unsigned long long pm = pr[0]; const unsigned long long lim = pm < 500000ull ? pm : 500000ull; while (__builtin_amdgcn_s_memrealtime() - t0 < lim) __builtin_amdgcn_s_sleep(8); }
    }
    if (PROBE == 6 || PROBE == 12) {
        if (F.tid == 0) atomicAdd((unsigned long long*)(F.ctl + CW_PROBE), (unsigned long long)pr[1]);
        GRID_BAR();
        if (blockIdx.x == 0 && F.tid == 0) { const unsigned long long tot = __hip_atomic_load((unsigned long long*)(F.ctl + CW_PROBE), RLX_AGENT) / (unsigned long long)F.G;
            const unsigned long long t0 = __builtin_amdgcn_s_memrealtime(); const unsigned long long lim = tot < 500000ull ? tot : 500000ull; while (__builtin_amdgcn_s_memrealtime() - t0 < lim) __builtin_amdgcn_s_sleep(8); }
    }
#undef IN
#undef BOTH
#undef GRID_BAR
}

extern "C" void kernel_launch(void* const* d_in, const int* in_sizes, int n_in, void* d_out, int out_size, void* d_ws, size_t ws_size, hipStream_t stream) {
    static int grid = 0;
    if (grid == 0) {
        if (n_in != 22 || in_sizes[0] != M_PROMPT * D || out_size != M * D || ws_size < WS_END) {
            fprintf(stderr, "kernel_launch: shape/workspace mismatch: n_in %d in0 %d out %d ws %zu (need %zu); nothing launched\n", n_in, n_in > 0 ? in_sizes[0] : -1, out_size, ws_size, (size_t)WS_END); grid = -1; return; }
        int dev = 0, cus = 0, per_cu = 0;
        if (hipGetDevice(&dev) != hipSuccess || hipDeviceGetAttribute(&cus, hipDeviceAttributeMultiprocessorCount, dev) != hipSuccess) { fprintf(stderr, "kernel_launch: device query failed\n"); grid = -1; return; }
        if (hipFuncSetAttribute((const void*)mk_fwd, hipFuncAttributeMaxDynamicSharedMemorySize, LDS_BYTES) != hipSuccess) { fprintf(stderr, "kernel_launch: hipFuncSetAttribute failed\n"); grid = -1; return; }
        if (hipOccupancyMaxActiveBlocksPerMultiprocessor(&per_cu, (const void*)mk_fwd, NWAVES * 64, LDS_BYTES) != hipSuccess || per_cu < 1) {
            fprintf(stderr, "kernel_launch: occupancy query reports %d workgroups per CU\n", per_cu); }
        (void)hipGetLastError();
        grid = cus;
    }
    if (grid < 0) return;
    if (hipMemsetAsync((char*)d_ws + WS_CTL, 0, CTL_ZERO_BYTES, stream) != hipSuccess) { fprintf(stderr, "kernel_launch: memset failed\n"); return; }
    Args a{};
    for (int i = 0; i < 22; ++i) a.in[i] = (const float*)d_in[i];
    a.out = (float*)d_out; a.ws = (unsigned char*)d_ws;
    if (N_LAUNCHES == 1) { a.ph_lo = 0; a.ph_hi = N_PHASES; hipLaunchKernelGGL(mk_fwd, dim3(grid), dim3(NWAVES * 64), LDS_BYTES, stream, a); }
    else for (int li = 0; li < N_PHASES; ++li) { a.ph_lo = li; a.ph_hi = li + 1; hipLaunchKernelGGL(mk_fwd, dim3(grid), dim3(NWAVES * 64), LDS_BYTES, stream, a); }
    const hipError_t le = hipPeekAtLastError();
    if (le != hipSuccess) fprintf(stderr, "kernel_launch: launch failed: %s\n", hipGetErrorName(le));
}
```

```cpp
#include <hip/hip_runtime.h>
#include <cstdio>
#include <cstdint>

namespace pg8 {
#define PG8_LAS __attribute__((address_space(3)))
typedef unsigned short bf16_t;
typedef short bf16x8 __attribute__((ext_vector_type(8)));
typedef float f32x4 __attribute__((ext_vector_type(4)));
typedef float f32x2 __attribute__((ext_vector_type(2)));
typedef unsigned u32x4 __attribute__((ext_vector_type(4)));
typedef unsigned u32x2 __attribute__((ext_vector_type(2)));
typedef int i32x4 __attribute__((ext_vector_type(4)));
constexpr int BM = 256, BK = 64, HALF = 128, HTB = HALF * BK * 2  , STAGE_BYTES = 8 * HTB, NXCD = 8, WGM = 8;

__host__ __device__ __forceinline__ int lds_byte(int r, int c) { const int st = (r >> 4) * 2 + (c >> 5), rr = r & 15, cc = c & 31, ob = rr * 64 + cc * 2; return st * 1024 + (ob ^ (((ob >> 9) & 1) << 5)); }
__host__ __device__ __forceinline__ void stage_rc(int b, int& R, int& C) { const int st = b / 1024, sb = b % 1024, swz = sb ^ (((sb >> 9) & 1) << 5); R = (st >> 1) * 16 + swz / 64; C = (st & 1) * 32 + (swz % 64) / 2; }
__host__ __device__ __forceinline__ int perm32(int rho) { const int n = rho >> 4, i = rho & 15; return 8 * (i >> 2) + 4 * n + (i & 3); }

struct Unit { int pm, pn; };
struct Gemm { const void* A; const void* Bt; int ldaB, ldbB, KB, a_cbytes, kstepA, kstepB; size_t tstepA, tstepB; };
__host__ __device__ __forceinline__ Gemm gemm_rm(const void* A, const void* Bt, int ldaB, int ldbB, int KB, int a_cbytes = 0) { return Gemm{A, Bt, ldaB, ldbB, KB, a_cbytes, 128, 128, (size_t)256 * ldaB, (size_t)256 * ldbB}; }
constexpr int TILE_BYTES = 32768;
__host__ __device__ __forceinline__ Gemm gemm_tiled(const void* A, const void* Bt, int KB) { return Gemm{A, Bt, 128, 128, KB, 0, TILE_BYTES, TILE_BYTES, (size_t)256 * KB, (size_t)256 * KB}; }

struct StaticOrder {
    int nM, nN, nwg, G, c, wgm, rev;
    __host__ __device__ void init(int M, int N, int G_, int c_, int wgm_ = WGM, int rev_ = 0) { nM = M / BM; nN = N / BM; nwg = nM * nN; G = G_; c = c_; wgm = wgm_; rev = rev_; }
    __host__ __device__ bool next(int i, Unit& u) const {
        const long L = (long)i * G + c; if (L >= nwg) return false;
        int wgid = (int)L; { const int q = nwg / NXCD, r = nwg % NXCD, xcd = wgid % NXCD, cnt = xcd < r ? q + 1 : q; int off = wgid / NXCD; if (rev) off = cnt - 1 - off; wgid = (xcd < r ? xcd * (q + 1) : r * (q + 1) + (xcd - r) * q) + off; }
        const int nig = wgm * nN, gid = wgid / nig, fm = gid * wgm, gsz = (nM - fm) < wgm ? (nM - fm) : wgm;
        u.pm = fm + ((wgid % nig) % gsz); u.pn = (wgid % nig) / gsz; return true;
    }
    __device__ __forceinline__ void a_ready(const Unit&) const {}
    __device__ __forceinline__ void done(const Unit&) const {}
};

struct MixOrder : StaticOrder {
    __device__ bool next(int i, Unit& u) const { if (!StaticOrder::next(i, u)) return false; const int p = u.pn, q = p / 3, r = p - 3 * q; u.pn = (r < 2) ? 2 * q + r : 16 + q; return true; }
};
__device__ __forceinline__ unsigned cvt_pk_bf16(float lo, float hi) { unsigned r; asm volatile("v_cvt_pk_bf16_f32 %0, %1, %2" : "=v"(r) : "v"(lo), "v"(hi)); return r; }
__device__ __forceinline__ f32x2 gelu_pk(f32x2 v) {
    const f32x2 av = __builtin_elementwise_abs(v), d = av * 0.2316418882f + 1.0f;
    f32x2 t; t.x = __builtin_amdgcn_rcpf(d.x); t.y = __builtin_amdgcn_rcpf(d.y);
    f32x2 q = t * 0.5307027145f + (-0.7265760135f); q = q * t + 0.7107068705f; q = q * t + (-0.142248368f); q = q * t + 0.127414796f; q = q * t;
    const f32x2 s = (v * v) * (-0.72134752044f);
    f32x2 e; e.x = __builtin_amdgcn_exp2f(s.x); e.y = __builtin_amdgcn_exp2f(s.y);
    const f32x2 m = v * (q * e), r = v - m;
    f32x2 o; o.x = v.x < 0.f ? m.x : r.x; o.y = v.y < 0.f ? m.y : r.y; return o;
}
__device__ __forceinline__ float silu_f(float g) { return g * __builtin_amdgcn_rcpf(1.0f + __builtin_amdgcn_exp2f(-1.44269504f * g)); }

struct EpiSwiGLU {
    static constexpr bool PERM = true, AFTER_DRAIN = false, I8 = false; typedef f32x4 acc_t;
    bf16_t* O; int ldc;
    __device__ __forceinline__ void operator()(const f32x4 (&acc)[2][2][4][2], const Unit& u, int wr, int wc, int fr, int fq) const {
        const int row0 = u.pm * BM + wr * 64 + fr, col0 = u.pn * HALF + wc * 32 + 8 * fq;
#pragma unroll
        for (int ai = 0; ai < 2; ++ai)
#pragma unroll
            for (int m = 0; m < 4; ++m) { bf16_t* rowp = O + (size_t)(row0 + ai * HALF + m * 16) * ldc + col0;
                const f32x4 g0 = acc[ai][0][m][0], g1 = acc[ai][0][m][1], u0 = acc[ai][1][m][0], u1 = acc[ai][1][m][1];
                u32x4 w;
                w.x = cvt_pk_bf16(silu_f(g0[0]) * u0[0], silu_f(g0[1]) * u0[1]); w.y = cvt_pk_bf16(silu_f(g0[2]) * u0[2], silu_f(g0[3]) * u0[3]);
                w.z = cvt_pk_bf16(silu_f(g1[0]) * u1[0], silu_f(g1[1]) * u1[1]); w.w = cvt_pk_bf16(silu_f(g1[2]) * u1[2], silu_f(g1[3]) * u1[3]);
                *(u32x4*)rowp = w; }
    }
};
struct EpiSwiGLUQ {
    static constexpr bool PERM = true, AFTER_DRAIN = false, I8 = true; typedef i32x4 acc_t;
    bf16_t* O; int ldc; const float* sa; const float* sw;
    __device__ __forceinline__ static f32x4 act4(const i32x4 G, const i32x4 U, const f32x4 kL, const f32x4 kP) {
        const f32x4 gf = __builtin_convertvector(G, f32x4), uf = __builtin_convertvector(U, f32x4);
        const f32x4 t = gf * kL; f32x4 d;
        d.x = __builtin_amdgcn_exp2f(t.x); d.y = __builtin_amdgcn_exp2f(t.y); d.z = __builtin_amdgcn_exp2f(t.z); d.w = __builtin_amdgcn_exp2f(t.w);
        d = d + 1.0f; f32x4 r;
        r.x = __builtin_amdgcn_rcpf(d.x); r.y = __builtin_amdgcn_rcpf(d.y); r.z = __builtin_amdgcn_rcpf(d.z); r.w = __builtin_amdgcn_rcpf(d.w);
        return ((gf * uf) * kP) * r;
    }
    __device__ __forceinline__ void operator()(const i32x4 (&acc)[2][2][4][2], const Unit& u, int wr, int wc, int fr, int fq) const {
        const int row0 = u.pm * BM + wr * 64 + fr;
        const float* swp = sw + u.pn * BM + wc * 32 + 8 * fq;
        const f32x4 sg0 = *(const f32x4*)(swp), sg1 = *(const f32x4*)(swp + 4), su0 = *(const f32x4*)(swp + HALF), su1 = *(const f32x4*)(swp + HALF + 4);
        const f32x4 gu0 = sg0 * su0, gu1 = sg1 * su1;
        float sr[2][4];
#pragma unroll
        for (int ai = 0; ai < 2; ++ai)
#pragma unroll
            for (int m = 0; m < 4; ++m) sr[ai][m] = sa[row0 + ai * HALF + m * 16];
#pragma unroll
        for (int ai = 0; ai < 2; ++ai)
#pragma unroll
            for (int m = 0; m < 4; ++m) { const float s = sr[ai][m];
                bf16_t* rowp = (bf16_t*)((char*)O + ((size_t)u.pm * (ldc / 64) + 2 * u.pn + (wc >> 1)) * TILE_BYTES + (wr * 64 + fr + ai * HALF + m * 16) * 128 + ((wc & 1) * 32 + 8 * fq) * 2);
                const float sl = s * -1.44269504f, ss = s * s;
                const f32x4 o0 = act4(acc[ai][0][m][0], acc[ai][1][m][0], sg0 * sl, gu0 * ss), o1 = act4(acc[ai][0][m][1], acc[ai][1][m][1], sg1 * sl, gu1 * ss);
                u32x4 w; w.x = cvt_pk_bf16(o0[0], o0[1]); w.y = cvt_pk_bf16(o0[2], o0[3]); w.z = cvt_pk_bf16(o1[0], o1[1]); w.w = cvt_pk_bf16(o1[2], o1[3]);
                __builtin_nontemporal_store(w, (u32x4*)rowp); }
    }
};
struct EpiYStats {
    static constexpr bool PERM = true, AFTER_DRAIN = false, I8 = false; typedef f32x4 acc_t;
    bf16_t* O; int ldc; float* stats;
    __device__ __forceinline__ void operator()(const f32x4 (&acc)[2][2][4][2], const Unit& u, int wr, int wc, int fr, int fq) const {
        const int row0 = u.pm * BM + wr * 64 + fr, col0 = u.pn * BM + wc * 32 + 8 * fq;
#pragma unroll
        for (int ai = 0; ai < 2; ++ai)
#pragma unroll
            for (int m = 0; m < 4; ++m) { const int row = row0 + ai * HALF + m * 16; bf16_t* rowp = O + (size_t)row * ldc + col0; float ss = 0.f;
#pragma unroll
                for (int bj = 0; bj < 2; ++bj) { const f32x4 v0 = acc[ai][bj][m][0], v1 = acc[ai][bj][m][1];
                    ss += (v0[0] * v0[0] + v0[1] * v0[1]) + (v0[2] * v0[2] + v0[3] * v0[3]) + (v1[0] * v1[0] + v1[1] * v1[1]) + (v1[2] * v1[2] + v1[3] * v1[3]);
                    u32x4 w; w.x = cvt_pk_bf16(v0[0], v0[1]); w.y = cvt_pk_bf16(v0[2], v0[3]); w.z = cvt_pk_bf16(v1[0], v1[1]); w.w = cvt_pk_bf16(v1[2], v1[3]);
                    *(u32x4*)(rowp + bj * HALF) = w; }
                ss += __shfl_xor(ss, 16); ss += __shfl_xor(ss, 32);
                if (fq == 0) stats[(size_t)row * 64 + u.pn * 4 + wc] = ss; }
    }
};
struct EpiZ {
    static constexpr bool PERM = true, AFTER_DRAIN = false, I8 = false; typedef f32x4 acc_t;
    bf16_t* O; int ldc; int gelu_tiles; const float* rs;
    __device__ __forceinline__ void operator()(const f32x4 (&acc)[2][2][4][2], const Unit& u, int wr, int wc, int fr, int fq) const {
        const int row0 = u.pm * BM + wr * 64 + fr, col0 = u.pn * BM + wc * 32 + 8 * fq; const bool act = u.pn < gelu_tiles;
        float sr[2][4];
#pragma unroll
        for (int ai = 0; ai < 2; ++ai)
#pragma unroll
            for (int m = 0; m < 4; ++m) sr[ai][m] = rs[row0 + ai * HALF + m * 16];
#pragma unroll
        for (int ai = 0; ai < 2; ++ai)
#pragma unroll
            for (int m = 0; m < 4; ++m) { bf16_t* rowp = O + (size_t)(row0 + ai * HALF + m * 16) * ldc + col0; const float s = sr[ai][m];
#pragma unroll
                for (int bj = 0; bj < 2; ++bj) { f32x4 v0 = acc[ai][bj][m][0] * s, v1 = acc[ai][bj][m][1] * s;
                    if (act) { const f32x2 a = gelu_pk((f32x2){v0[0], v0[1]}), b = gelu_pk((f32x2){v0[2], v0[3]}), c = gelu_pk((f32x2){v1[0], v1[1]}), d = gelu_pk((f32x2){v1[2], v1[3]});
                        v0 = (f32x4){a.x, a.y, b.x, b.y}; v1 = (f32x4){c.x, c.y, d.x, d.y}; }
                    u32x4 w; w.x = cvt_pk_bf16(v0[0], v0[1]); w.y = cvt_pk_bf16(v0[2], v0[3]); w.z = cvt_pk_bf16(v1[0], v1[1]); w.w = cvt_pk_bf16(v1[2], v1[3]);
                    *(u32x4*)(rowp + bj * HALF) = w; } }
    }
};
struct EpiScale {
    static constexpr bool PERM = true, AFTER_DRAIN = false, I8 = false; typedef f32x4 acc_t;
    bf16_t* O; int ldc; int ocol; const float* scale;
    __device__ __forceinline__ void operator()(const f32x4 (&acc)[2][2][4][2], const Unit& u, int wr, int wc, int fr, int fq) const {
        const int row0 = u.pm * BM + wr * 64 + fr, col0 = u.pn * BM + wc * 32 + 8 * fq;
        f32x4 sv[2][2];
#pragma unroll
        for (int bj = 0; bj < 2; ++bj)
#pragma unroll
            for (int n = 0; n < 2; ++n) sv[bj][n] = *(const f32x4*)(scale + col0 + bj * HALF + 4 * n);
#pragma unroll
        for (int ai = 0; ai < 2; ++ai)
#pragma unroll
            for (int m = 0; m < 4; ++m) { bf16_t* rowp = O + (size_t)(row0 + ai * HALF + m * 16) * ldc + ocol + col0;
#pragma unroll
                for (int bj = 0; bj < 2; ++bj) { const f32x4 v0 = acc[ai][bj][m][0] * sv[bj][0], v1 = acc[ai][bj][m][1] * sv[bj][1];
                    u32x4 w; w.x = cvt_pk_bf16(v0[0], v0[1]); w.y = cvt_pk_bf16(v0[2], v0[3]); w.z = cvt_pk_bf16(v1[0], v1[1]); w.w = cvt_pk_bf16(v1[2], v1[3]);
                    *(u32x4*)(rowp + bj * HALF) = w; } }
    }
};

template <bool I8> __device__ __forceinline__ f32x4 mma1(i32x4 b, i32x4 a, f32x4 c) { return __builtin_amdgcn_mfma_f32_16x16x32_bf16(__builtin_bit_cast(bf16x8, b), __builtin_bit_cast(bf16x8, a), c, 0, 0, 0); }
template <bool I8> __device__ __forceinline__ i32x4 mma1(i32x4 b, i32x4 a, i32x4 c) { return __builtin_amdgcn_mfma_i32_16x16x64_i8(b, a, c, 0, 0, 0); }
template <class Epi, class Sched, bool ALIGN_EPI>
__device__ __forceinline__ void gemm_phase(PG8_LAS unsigned char* lds, const Gemm g, const Sched& S, const Epi& E) {
    const int tid = threadIdx.x, wid = __builtin_amdgcn_readfirstlane(tid >> 6), lane = tid & 63, wr = wid >> 2, wc = wid & 3, fr = lane & 15, fq = lane >> 4;
    const int nt = g.KB / (BK * 2);
    typedef typename Epi::acc_t acc_t; typedef i32x4 frag_t;
    unsigned voffA[2], voffB[2];
#pragma unroll
    for (int i = 0; i < 2; ++i) { int R, C; stage_rc(tid * 16 + i * 8192, R, C); const int Rb = Epi::PERM ? ((R & ~31) + perm32(R & 31)) : R;
        voffA[i] = (unsigned)(R * g.ldaB + C * 2); voffB[i] = (unsigned)(Rb * g.ldbB + C * 2); }
    const size_t kstepA = (size_t)g.kstepA, kstepB = (size_t)g.kstepB;
    const size_t hstepA = (size_t)HALF * g.ldaB, hstepB = (size_t)HALF * g.ldbB;
    const size_t tstepA = g.tstepA, tstepB = g.tstepB;
    const size_t acstep = (size_t)g.a_cbytes;
    const unsigned ldsw = (unsigned)wid * 1024u;
    const int aoff = lds_byte(wr * 64 + fr, fq * 8), boff = lds_byte(wc * 32 + fr, fq * 8);
#define PG8_SA(b, h) (((b) * 2 + (h)) * HTB)
#define PG8_SB(b, h) ((4 + (b) * 2 + (h)) * HTB)
#define PG8_STAGE(bufoff, gbase, voff) do { _Pragma("unroll") for (int _i = 0; _i < 2; ++_i) \
        __builtin_amdgcn_global_load_lds((const unsigned*)((const char*)(gbase) + (voff)[_i]), (PG8_LAS unsigned*)(lds + (bufoff) + ldsw + _i * 8192), 16, 0, 0); } while (0)
#define PG8_LDA(dst, b, h) do { _Pragma("unroll") for (int m = 0; m < 4; ++m) _Pragma("unroll") for (int k = 0; k < 2; ++k) dst[m][k] = *(const PG8_LAS frag_t*)(lds + PG8_SA(b, h) + aoff + m * 2048 + k * 1024); } while (0)
#define PG8_LDB(dst, b, h) do { _Pragma("unroll") for (int n = 0; n < 2; ++n) _Pragma("unroll") for (int k = 0; k < 2; ++k) dst[n][k] = *(const PG8_LAS frag_t*)(lds + PG8_SB(b, h) + boff + n * 2048 + k * 1024); } while (0)
#define PG8_MMA(ai, bj, At, Bt) do { __builtin_amdgcn_s_setprio(1); _Pragma("unroll") for (int m = 0; m < 4; ++m) _Pragma("unroll") for (int n = 0; n < 2; ++n) _Pragma("unroll") for (int k = 0; k < 2; ++k) \
        acc[ai][bj][m][n] = mma1<Epi::I8>(Bt[n][k], At[m][k], acc[ai][bj][m][n]); __builtin_amdgcn_s_setprio(0); } while (0)
#define PG8_WAIT_V(n) asm volatile("s_waitcnt vmcnt(" #n ")" ::: "memory")
#define PG8_WAIT_L(n) asm volatile("s_waitcnt lgkmcnt(" #n ")" ::: "memory")
#define PG8_BAR __builtin_amdgcn_s_barrier()
#define PG8_SCHED __builtin_amdgcn_sched_barrier(0)
#define PG8_UA(u) ((const char*)g.A + (size_t)(u).pm * tstepA + (size_t)((u).pn >> 1) * acstep)
#define PG8_UB(u) ((const char*)g.Bt + (size_t)(u).pn * tstepB)
    Unit cur, nxt; int ui = 0;
    if (!S.next(0, cur)) return;
    acc_t acc[2][2][4][2];
#pragma unroll
    for (int a = 0; a < 2; ++a)
#pragma unroll
        for (int b = 0; b < 2; ++b)
#pragma unroll
            for (int m = 0; m < 4; ++m)
#pragma unroll
                for (int n = 0; n < 2; ++n) acc[a][b][m][n] = (acc_t){0, 0, 0, 0};
    frag_t At[4][2], B0[2][2], B1[2][2];
    const char* cA = PG8_UA(cur); const char* cB = PG8_UB(cur);
    S.a_ready(cur);
    PG8_STAGE(PG8_SB(0, 0), cB, voffB); PG8_STAGE(PG8_SB(0, 1), cB + hstepB, voffB); PG8_STAGE(PG8_SA(0, 0), cA, voffA); PG8_STAGE(PG8_SA(0, 1), cA + hstepA, voffA);
    if (wr == 1) PG8_BAR;
    PG8_WAIT_V(2); PG8_BAR;
    PG8_STAGE(PG8_SB(1, 0), cB + kstepB, voffB); PG8_STAGE(PG8_SA(1, 0), cA + kstepA, voffA); PG8_STAGE(PG8_SB(1, 1), cB + hstepB + kstepB, voffB);
    PG8_WAIT_V(6); PG8_BAR;
    for (;;) {
        const bool has_next = S.next(ui + 1, nxt);
        const char* nA = has_next ? PG8_UA(nxt) : cA; const char* nB = has_next ? PG8_UB(nxt) : cB;
        for (int t = 0; t < nt; t += 2) {
            const bool last = (t == nt - 2);
            const char* a1 = cA + (size_t)(t + 1) * kstepA;
            const char* a2 = last ? nA : cA + (size_t)(t + 2) * kstepA; const char* b2 = last ? nB : cB + (size_t)(t + 2) * kstepB;
            const char* a3 = a2 + kstepA; const char* b3 = b2 + kstepB;
            if (last && has_next) S.a_ready(nxt);
            PG8_LDB(B0, 0, 0); PG8_LDB(B1, 0, 1); PG8_SCHED; PG8_LDA(At, 0, 0); PG8_STAGE(PG8_SA(1, 1), a1 + hstepA, voffA);
            PG8_WAIT_V(8); PG8_WAIT_L(0); PG8_BAR; PG8_MMA(0, 0, At, B0); PG8_MMA(0, 1, At, B1); PG8_BAR; PG8_SCHED;
            PG8_LDA(At, 0, 1); PG8_STAGE(PG8_SB(0, 0), b2, voffB); PG8_STAGE(PG8_SB(0, 1), b2 + hstepB, voffB); PG8_STAGE(PG8_SA(0, 0), a2, voffA);
            PG8_WAIT_V(8); PG8_WAIT_L(0); PG8_BAR; PG8_MMA(1, 0, At, B0); PG8_MMA(1, 1, At, B1); PG8_BAR; PG8_SCHED;
            PG8_LDB(B0, 1, 0); PG8_LDB(B1, 1, 1); PG8_SCHED; PG8_LDA(At, 1, 0); PG8_STAGE(PG8_SA(0, 1), a2 + hstepA, voffA);
            PG8_WAIT_V(8); PG8_WAIT_L(0); PG8_BAR; PG8_MMA(0, 0, At, B0); PG8_MMA(0, 1, At, B1); PG8_BAR; PG8_SCHED;
            PG8_LDA(At, 1, 1); PG8_STAGE(PG8_SB(1, 0), b3, voffB); PG8_STAGE(PG8_SB(1, 1), b3 + hstepB, voffB); PG8_STAGE(PG8_SA(1, 0), a3, voffA);
            PG8_WAIT_V(8); PG8_WAIT_L(0); PG8_BAR; PG8_MMA(1, 0, At, B0); PG8_MMA(1, 1, At, B1); PG8_BAR; PG8_SCHED;
        }
        if constexpr (ALIGN_EPI) { if (wr == 0) PG8_BAR; }
        E(acc, cur, wr, wc, fr, fq); S.done(cur);
        if (!has_next) break;
#pragma unroll
        for (int a = 0; a < 2; ++a)
#pragma unroll
            for (int b = 0; b < 2; ++b)
#pragma unroll
                for (int m = 0; m < 4; ++m)
#pragma unroll
                    for (int n = 0; n < 2; ++n) acc[a][b][m][n] = (acc_t){0, 0, 0, 0};
        cur = nxt; cA = nA; cB = nB; ++ui;
        if constexpr (ALIGN_EPI) { if (wr == 1) PG8_BAR; }
    }
    PG8_WAIT_V(0);
    if constexpr (!ALIGN_EPI) { if (wr == 0) PG8_BAR; }
    PG8_BAR;
#undef PG8_SA
#undef PG8_SB
#undef PG8_STAGE
#undef PG8_LDA
#undef PG8_LDB
#undef PG8_MMA
#undef PG8_WAIT_V
#undef PG8_WAIT_L
#undef PG8_BAR
#undef PG8_SCHED
#undef PG8_UA
#undef PG8_UB
}
}

constexpr int NWAVES = 8;
#ifndef MK_N_LAUNCHES
#define MK_N_LAUNCHES 1
#endif
constexpr int N_PHASES = 13;
#ifndef WGM_GU
#define WGM_GU 4
#endif
#ifndef BG_IN_P2
#define BG_IN_P2 1
#endif
#ifndef WD2_IN_P10
#define WD2_IN_P10 1
#endif
#ifndef BG_TR
#define BG_TR 1
#endif
#ifndef NBG
#define NBG 0
#endif
#ifndef REV_DOWN
#define REV_DOWN 1
#endif
#ifndef WGM_DOWN
#define WGM_DOWN 4
#endif
#ifndef PROBE
#define PROBE 0
#endif
#ifndef PROBE_PH
#define PROBE_PH 0
#endif
constexpr int N_LAUNCHES = MK_N_LAUNCHES;
static_assert(N_LAUNCHES == 1 || N_LAUNCHES == N_PHASES, "MK_N_LAUNCHES is 1 or 13");

constexpr int M = 24576, M_PROMPT = 16384, SEQ_P = 8192, SEQ_S = 2048;
constexpr int D = 4096, FF = 11008, NGU = 2 * FF, DIN = 6144, DA = 2048, DB = 2048, NH = 16, HD = 128, CH = 128, DPG = 512;
constexpr float EPS = 1e-6f;

constexpr size_t MiB = 1u << 20;
constexpr size_t WS_CTL = 0, CTL_ZERO_BYTES = 64 * 1024;
constexpr size_t WS_STATS = 1 * MiB;
constexpr size_t WS_SA = 7 * MiB, WS_SW1 = 7 * MiB + 256 * 1024, WS_SW2 = 7 * MiB + 512 * 1024;
constexpr size_t WS_WGU1 = 8 * MiB, WS_WD1 = 94 * MiB, WS_WGU2 = 180 * MiB, WS_WD2 = 266 * MiB;
constexpr size_t WS_WIN = 352 * MiB, WS_WOUT = 400 * MiB, WS_WSP = 432 * MiB, WS_WPT = 433 * MiB;
constexpr size_t WS_A = 436 * MiB;
constexpr size_t WS_HID = 628 * MiB;
constexpr size_t WS_Z = WS_HID, WS_YCAT = WS_HID + 288 * MiB;
constexpr size_t WS_Y = 1144 * MiB;
constexpr size_t WS_END = 1336 * MiB;
static_assert((4096 + 3456) * 4 <= (int)CTL_ZERO_BYTES && WS_STATS + (size_t)M * 64 * 4 <= WS_SA && WS_SA + (size_t)M * 4 <= WS_SW1 && WS_SW1 + NGU * 4 <= WS_SW2 && WS_SW2 + NGU * 4 <= WS_WGU1, "ws map 0");
static_assert(WS_WGU1 + (size_t)NGU * D <= WS_WD1 && WS_WD1 + (size_t)D * FF * 2 <= WS_WGU2 && WS_WGU2 + (size_t)NGU * D <= WS_WD2 && WS_WD2 + (size_t)D * FF * 2 <= WS_WIN, "ws map 1");
static_assert(WS_WIN + (size_t)DIN * D * 2 <= WS_WOUT && WS_WOUT + (size_t)D * D * 2 <= WS_WSP && WS_WSP + (size_t)NH * CH * CH * 2 <= WS_WPT && WS_WPT + (size_t)DB * DPG * 2 <= WS_A, "ws map 2");
static_assert(WS_A + (size_t)M * D * 2 <= WS_HID && WS_HID + (size_t)M * FF * 2 <= WS_Y && WS_Y + (size_t)M * D * 2 <= WS_END && WS_YCAT + (size_t)M * D * 2 <= WS_Y && WS_Z + (size_t)M * DIN * 2 <= WS_YCAT, "ws map 3");
constexpr int CW_TMO = 0, CW_CODE = 1;
constexpr int CW_BAR = 4096, CW_BAR_END = CW_BAR + 3456;
constexpr int CW_PROBE = 512, CW_QUEUE = 640, CW_QUEUE2 = 704, CW_QUEUE3 = 768;

constexpr int RING_OFF = 0, RING_BYTES = 131072;
constexpr int LDSCTL_OFF = RING_BYTES, MISC_OFF = LDSCTL_OFF + 320;
constexpr int LDSX_OFF = LDSCTL_OFF + 1024;
constexpr int LDS_BYTES = 147456;
static_assert(MISC_OFF + 128 <= LDSX_OFF && LDSX_OFF + 4096 <= LDS_BYTES, "LDS map");

#define GAS __attribute__((address_space(1)))
#define LAS __attribute__((address_space(3)))
typedef unsigned short bf16;
typedef unsigned v4u __attribute__((ext_vector_type(4)));
typedef unsigned v2u __attribute__((ext_vector_type(2)));
typedef float f32x4 __attribute__((ext_vector_type(4)));
typedef short bf16x8 __attribute__((ext_vector_type(8)));
typedef GAS unsigned gu32;
#define RLX_AGENT __ATOMIC_RELAXED, __HIP_MEMORY_SCOPE_AGENT
#define LDS_WAIT() asm volatile("s_waitcnt lgkmcnt(0)" ::: "memory")
#define VM_WAIT() asm volatile("s_waitcnt vmcnt(0)" ::: "memory")
__device__ __forceinline__ unsigned f2bf(float f) { unsigned u = __builtin_bit_cast(unsigned, f); return (u + 0x7fffu + ((u >> 16) & 1u)) >> 16; }
__device__ __forceinline__ unsigned pk2(float lo, float hi) { return f2bf(lo) | (f2bf(hi) << 16); }
__device__ __forceinline__ float bf_lo(unsigned w) { return __builtin_bit_cast(float, w << 16); }
__device__ __forceinline__ float bf_hi(unsigned w) { return __builtin_bit_cast(float, w & 0xffff0000u); }
__device__ __forceinline__ unsigned q8(float v) { return (unsigned)(int)__builtin_rintf(v) & 255u; }
__device__ __forceinline__ unsigned pk4q(float a, float b, float c, float d) { return q8(a) | (q8(b) << 8) | (q8(c) << 16) | (q8(d) << 24); }

#define XB_TMO      128
#define XB_XCNT(j)  (256  + 64 * (j))
#define XB_XSUB(j)  (1280 + 64 * (j))
#define XB_XGEN(j)  (2304 + 64 * (j))
#define XB_TOP      3328
#define XB_TOPGEN   3392
#define XCD_BAR_WORDS 3456
#define XB_SPIN_CAP (1u << 18)

__device__ __forceinline__ unsigned xb_ld(unsigned* p)              { return __hip_atomic_load(p, __ATOMIC_RELAXED, __HIP_MEMORY_SCOPE_AGENT); }
__device__ __forceinline__ unsigned xb_add(unsigned* p, unsigned v) { return __hip_atomic_fetch_add(p, v, __ATOMIC_RELAXED, __HIP_MEMORY_SCOPE_AGENT); }
__device__ __forceinline__ unsigned xb_xcc_id() { return (unsigned)__builtin_amdgcn_s_getreg((3 << 11) | 20) & 0xFu; }
#define XB_SPIN(cond, bar) do { unsigned _sp = 0; while (cond) { __builtin_amdgcn_s_sleep(1); \
    if ((++_sp & 255u) == 0u) { if (xb_ld(&(bar)[XB_TMO])) break; if (_sp > XB_SPIN_CAP) { atomicAdd(&(bar)[XB_TMO], 1u); break; } } } } while (0)

struct XcdBarrier {
    unsigned* bar; unsigned x;
    volatile LAS unsigned* st;
};

__device__ __forceinline__ XcdBarrier xcd_barrier_post(unsigned* bar, volatile LAS unsigned* st) {
    XcdBarrier b; b.bar = bar; b.x = xb_xcc_id(); b.st = st;
    if (threadIdx.x == 0) (void)xb_add(&bar[XB_XCNT(b.x)], 1u);
    return b;
}
__device__ __forceinline__ void xcd_barrier_complete(unsigned* bar, unsigned x, unsigned& nloc, unsigned& nx) {
    const unsigned G = gridDim.x * gridDim.y * gridDim.z;
    unsigned sum, cnt, mine, sp = 0u;
    for (;;) {
        sum = 0u; cnt = 0u; mine = 0u;
#pragma unroll
        for (unsigned j = 0; j < 16; ++j) { const unsigned c = xb_ld(&bar[XB_XCNT(j)]); sum += c; cnt += (c > 0u) ? 1u : 0u; mine = (j == x) ? c : mine; }
        if (sum == G) break;
        __builtin_amdgcn_s_sleep(1);
        if ((++sp & 255u) == 0u) { if (xb_ld(&bar[XB_TMO])) break; if (sp > XB_SPIN_CAP) { atomicAdd(&bar[XB_TMO], 1u); break; } }
    }
    nloc = mine > 0u ? mine : 1u; nx = cnt > 0u ? cnt : 1u;
}

__device__ __forceinline__ void xcd_barrier(const XcdBarrier& b) {
    asm volatile("s_waitcnt vmcnt(0)" ::: "memory");
    __syncthreads();
    if (threadIdx.x == 0) {
        unsigned* bar = b.bar;
        __builtin_amdgcn_s_waitcnt(0);
        unsigned nloc = b.st[0], nx = b.st[1];
        if (nloc == 0u) { xcd_barrier_complete(bar, b.x, nloc, nx); b.st[0] = nloc; b.st[1] = nx; }
        const unsigned old = xb_add(&bar[XB_XSUB(b.x)], 1u);
        const unsigned gen = old / nloc;
        if (old + 1u == (gen + 1u) * nloc) {
            __builtin_amdgcn_fence(__ATOMIC_RELEASE, "agent");
            asm volatile("s_waitcnt vmcnt(0)" ::: "memory");
            const unsigned og = xb_add(&bar[XB_TOP], 1u);
            const unsigned tg = og / nx;
            if (og + 1u == (tg + 1u) * nx) xb_add(&bar[XB_TOPGEN], 1u);
            else XB_SPIN(xb_ld(&bar[XB_TOPGEN]) == tg, bar);
            __builtin_amdgcn_fence(__ATOMIC_ACQUIRE, "agent");
            xb_add(&bar[XB_XGEN(b.x)], 1u);
            asm volatile("s_waitcnt vmcnt(0)" ::: "memory");
        } else {
            XB_SPIN(xb_ld(&bar[XB_XGEN(b.x)]) == gen, bar);
            __builtin_amdgcn_fence(__ATOMIC_ACQUIRE, "agent");
            asm volatile("s_waitcnt vmcnt(0)" ::: "memory");
        }
    }
    __syncthreads();
}

struct Frame {
    LAS unsigned char* lds;
    volatile LAS unsigned* MISC;
    gu32* ctl;
    int tid, lane, wave;
    int vcu, G;
};

__device__ __forceinline__ float wave_sum(float v) {
#pragma unroll
    for (int o = 1; o < 64; o <<= 1) v += __shfl_xor(v, o);
    return v;
}
__device__ __forceinline__ float wave_max(float v) {
#pragma unroll
    for (int o = 1; o < 64; o <<= 1) v = fmaxf(v, __shfl_xor(v, o));
    return v;
}
template <bool TILED>
__device__ __forceinline__ void p0_transpose_item(const float* W, int K, int N, bf16* WT, int row_off, LAS float* scr, int item, int lane) {
    const int nblk = N / 32, kb = item / nblk, nb = item % nblk, k0 = 64 * kb, n0 = 32 * nb;
#pragma unroll 8
    for (int i = 0; i < 32; ++i) { const int kk = 2 * i + (lane >> 5); scr[kk * 33 + (lane & 31)] = W[(size_t)(k0 + kk) * N + n0 + (lane & 31)]; }
    LDS_WAIT(); asm volatile("" ::: "memory");
    const int c = lane & 7;
#pragma unroll
    for (int j = 0; j < 4; ++j) { const int n = (lane >> 3) + 8 * j; const LAS float* s = scr + (8 * c) * 33 + n;
        v4u o; o.x = pk2(s[0 * 33], s[1 * 33]); o.y = pk2(s[2 * 33], s[3 * 33]); o.z = pk2(s[4 * 33], s[5 * 33]); o.w = pk2(s[6 * 33], s[7 * 33]);
        if constexpr (TILED) { const int r = row_off + n0 + n;
            *(GAS v4u*)((GAS char*)WT + ((size_t)(r >> 8) * (K / 64) + kb) * 32768 + (r & 255) * 128 + 16 * c) = o; }
        else *(GAS v4u*)(WT + (size_t)(row_off + n0 + n) * K + k0 + 8 * c) = o; }
    LDS_WAIT(); asm volatile("" ::: "memory");
}
struct TJob { const float* W; bf16* WT; int K, N, row_off, tiled; const float* ks; };
__device__ __forceinline__ void tr_load(const TJob& J, int item, int lane, f32x4 (&v)[8]) {
    const int nblk = J.N / 32, kb = item / nblk, nb = item % nblk;
    const GAS f32x4* p = (const GAS f32x4*)(J.W + (size_t)(64 * kb + (lane >> 3)) * J.N + 32 * nb) + (lane & 7);
#pragma unroll
    for (int i = 0; i < 8; ++i) v[i] = __builtin_nontemporal_load(&p[(size_t)i * 8 * (J.N / 4)]);
    if (J.ks) {
        float s[8];
#pragma unroll
        for (int i = 0; i < 8; ++i) s[i] = J.ks[64 * kb + (lane >> 3) + 8 * i];
#pragma unroll
        for (int i = 0; i < 8; ++i) v[i] = v[i] * s[i];
    }
}
__device__ __forceinline__ void tr_commit(const TJob& J, int item, int lane, const f32x4 (&v)[8], LAS float* scr) {
    const int nblk = J.N / 32, kb = item / nblk, nb = item % nblk, k0 = 64 * kb, n0 = 32 * nb;
#pragma unroll
    for (int i = 0; i < 8; ++i) { LAS float* d = scr + (8 * i + (lane >> 3)) * 33 + 4 * (lane & 7); d[0] = v[i].x; d[1] = v[i].y; d[2] = v[i].z; d[3] = v[i].w; }
    LDS_WAIT(); asm volatile("" ::: "memory");
    const int c = lane & 7;
#pragma unroll
    for (int j = 0; j < 4; ++j) { const int n = (lane >> 3) + 8 * j; const LAS float* s = scr + (8 * c) * 33 + n;
        v4u o; o.x = pk2(s[0 * 33], s[1 * 33]); o.y = pk2(s[2 * 33], s[3 * 33]); o.z = pk2(s[4 * 33], s[5 * 33]); o.w = pk2(s[6 * 33], s[7 * 33]);
        const int r = J.row_off + n0 + n;
        if (J.tiled) __builtin_nontemporal_store(o, (GAS v4u*)((GAS char*)J.WT + ((size_t)(r >> 8) * (J.K / 64) + kb) * 32768 + (r & 255) * 128 + 16 * c));
        else __builtin_nontemporal_store(o, (GAS v4u*)(J.WT + (size_t)r * J.K + k0 + 8 * c)); }
    LDS_WAIT(); asm volatile("" ::: "memory");
}
__device__ __forceinline__ void p0_quant_item2(const float* W, float cm, signed char* WQ, int drow0, LAS float* scr, int kb, int n0, int lane) {
    const int k0 = 64 * kb;
#pragma unroll 8
    for (int i = 0; i < 32; ++i) { const int kk = 2 * i + (lane >> 5); scr[kk * 33 + (lane & 31)] = W[(size_t)(k0 + kk) * FF + n0 + (lane & 31)]; }
    LDS_WAIT(); asm volatile("" ::: "memory");
    const int c = lane & 3;
#pragma unroll
    for (int j = 0; j < 2; ++j) { const int n = (lane >> 2) + 16 * j; const LAS float* s = scr + (16 * c) * 33 + n;
        const float mxv = __shfl(cm, n); const float inv = mxv > 0.f ? 127.0f / mxv : 0.f;
        v4u o; o.x = pk4q(s[0 * 33] * inv, s[1 * 33] * inv, s[2 * 33] * inv, s[3 * 33] * inv); o.y = pk4q(s[4 * 33] * inv, s[5 * 33] * inv, s[6 * 33] * inv, s[7 * 33] * inv);
        o.z = pk4q(s[8 * 33] * inv, s[9 * 33] * inv, s[10 * 33] * inv, s[11 * 33] * inv); o.w = pk4q(s[12 * 33] * inv, s[13 * 33] * inv, s[14 * 33] * inv, s[15 * 33] * inv);
        *(GAS v4u*)(WQ + (size_t)(drow0 + n) * D + k0 + 16 * c) = o; }
    LDS_WAIT(); asm volatile("" ::: "memory");
}
__device__ __forceinline__ const float* x_row(const float* xp, const float* xs, int m) { return m < M_PROMPT ? xp + (size_t)m * D : xs + (size_t)(m - M_PROMPT) * D; }

__device__ __forceinline__ void quant_row_store(int lane, const f32x4 (&a)[16], signed char* qrow, float* sa) {
    float mx = 0.f;
#pragma unroll
    for (int j = 0; j < 16; ++j) mx = fmaxf(fmaxf(mx, fmaxf(fabsf(a[j].x), fabsf(a[j].y))), fmaxf(fabsf(a[j].z), fabsf(a[j].w)));
    mx = wave_max(mx);
    const float inv = mx > 0.f ? 127.0f / mx : 0.f;
    GAS unsigned* o = (GAS unsigned*)qrow + lane;
#pragma unroll
    for (int j = 0; j < 16; ++j) o[64 * j] = pk4q(a[j].x * inv, a[j].y * inv, a[j].z * inv, a[j].w * inv);
    if (lane == 0) *sa = mx > 0.f ? mx * (1.0f / 127.0f) : 1.0f;
}
__device__ __forceinline__ void rms_row_to_q(int lane, const float* xrow, const float* g, signed char* qrow, float* sa) {
    const GAS f32x4* xr = (const GAS f32x4*)xrow + lane; const GAS f32x4* gr = (const GAS f32x4*)g + lane;
    f32x4 v[16]; float s = 0.f;
#pragma unroll
    for (int j = 0; j < 16; ++j) v[j] = __builtin_nontemporal_load(&xr[64 * j]);
    __builtin_amdgcn_sched_barrier(0);
#pragma unroll
    for (int j = 0; j < 16; ++j) s += (v[j].x * v[j].x + v[j].y * v[j].y) + (v[j].z * v[j].z + v[j].w * v[j].w);
    const float r = 1.0f / sqrtf(wave_sum(s) * (1.f / D) + EPS);
#pragma unroll
    for (int j = 0; j < 16; ++j) v[j] = v[j] * r * gr[64 * j];
    quant_row_store(lane, v, qrow, sa);
}

template <int MODE, bool BASE_X, int DIR>
__device__ __forceinline__ void norm_phase(Frame& F, const float* baseP, const float* baseS, const bf16* Y, const float* stats, float c, const float* gpost, const float* g2, float* OUT, bf16* A, signed char* AQ, float* SA) {
    LAS f32x4* gl = (LAS f32x4*)(F.lds + RING_OFF);
    for (int i = F.tid; i < D / 4; i += NWAVES * 64) { gl[i] = ((const GAS f32x4*)gpost)[i]; gl[1024 + i] = ((const GAS f32x4*)g2)[i]; }
    LDS_WAIT(); __syncthreads();
    const int lane = F.lane, nx = (F.G % 8 == 0) ? 8 : 1, gpx = F.G / nx, MX = M / nx, wpx = gpx * NWAVES, xq = F.vcu / gpx, j0 = (F.vcu % gpx) * NWAVES + F.wave;
    for (int j = j0; j < MX; j += wpx) {
        const int m = xq * MX + (DIR ? MX - 1 - j : j);
        const GAS f32x4* br = (const GAS f32x4*)x_row(baseP, baseS, m) + lane;
        GAS v2u* hb = (GAS v2u*)((bf16*)(OUT + (size_t)m * D) + D) + lane;
        const GAS v2u* yr = (const GAS v2u*)(Y + (size_t)m * D) + lane;
        const float ssy = wave_sum(stats[(size_t)m * 64 + lane]);
        const float ry = c / sqrtf(ssy * (1.f / D) + EPS);
        constexpr int NB = (PROBE != 0) ? 8 : 16;
        f32x4 h[16]; v2u yv[NB], bv[BASE_X ? 1 : NB]; float s = 0.f;
#pragma unroll
        for (int jb = 0; jb < 16; jb += NB) {
#pragma unroll
            for (int j = 0; j < NB; ++j) { if constexpr (BASE_X) h[jb + j] = br[64 * (jb + j)]; else bv[j] = hb[64 * (jb + j)];
                yv[j] = yr[64 * (jb + j)]; }
            __builtin_amdgcn_sched_barrier(0);
#pragma unroll
            for (int j = 0; j < NB; ++j) { f32x4 b; if constexpr (BASE_X) b = h[jb + j]; else { const v2u bb = bv[j]; b.x = bf_lo(bb.x); b.y = bf_hi(bb.x); b.z = bf_lo(bb.y); b.w = bf_hi(bb.y); }
                const v2u yy = yv[j]; const f32x4 gp = gl[64 * (jb + j) + lane];
                f32x4 y; y.x = bf_lo(yy.x); y.y = bf_hi(yy.x); y.z = bf_lo(yy.y); y.w = bf_hi(yy.y);
                h[jb + j] = b + y * ry * gp; s += (h[jb + j].x * h[jb + j].x + h[jb + j].y * h[jb + j].y) + (h[jb + j].z * h[jb + j].z + h[jb + j].w * h[jb + j].w); }
            if (NB < 16) __builtin_amdgcn_sched_barrier(0);
        }
        const float rh = 1.0f / sqrtf(wave_sum(s) * (1.f / D) + EPS);
        if constexpr (MODE == 1) {
            GAS f32x4* ho = (GAS f32x4*)(OUT + (size_t)m * D) + lane;
#pragma unroll
            for (int j = 0; j < 16; ++j) { const f32x4 gg = gl[1024 + 64 * j + lane]; ho[64 * j] = h[j] * rh * gg; }
        } else if constexpr (MODE == 0) {
#pragma unroll
            for (int j = 0; j < 16; ++j) { v2u hw; hw.x = pk2(h[j].x, h[j].y); hw.y = pk2(h[j].z, h[j].w); hb[64 * j] = hw; }
            if (lane == 0) SA[m] = rh;
        } else {
#pragma unroll
            for (int j = 0; j < 16; ++j) { const f32x4 gg = gl[1024 + 64 * j + lane]; v2u hw; hw.x = pk2(h[j].x, h[j].y); hw.y = pk2(h[j].z, h[j].w); hb[64 * j] = hw; h[j] = h[j] * rh * gg; }
            quant_row_store(lane, h, AQ + (size_t)m * D, SA + m);
        }
    }
}

__device__ __forceinline__ void spatial_units(Frame& F, int u0, int u1, const bf16* Z, const bf16* WSP, const float* b_sp, const float* v_norm, bf16* YCAT) {
    constexpr int VS = 136, VBUF = 128 * VS * 2;
    const int tid = F.tid, s = tid >> 2, q = tid & 3, w = F.wave, fr = F.lane & 15, fq = F.lane >> 4, t = 16 * w + fr;
    if (u0 >= u1) return;
    v4u vw[4];
    { const GAS v4u* src = (const GAS v4u*)(Z + (size_t)((u0 / NH) * CH + s) * DIN + DA + (u0 % NH) * HD + q * 32);
#pragma unroll
      for (int i = 0; i < 4; ++i) vw[i] = src[i]; }
    for (int ui = u0; ui < u1; ++ui) {
        const int cidx = ui / NH, h = ui % NH, r0 = cidx * CH;
        LAS bf16* vT = (LAS bf16*)(F.lds + RING_OFF + ((ui - u0) & 1) * VBUF);
        bf16x8 af[4];
#pragma unroll
        for (int kk = 0; kk < 4; ++kk) af[kk] = *(const GAS bf16x8*)(WSP + (size_t)h * CH * CH + t * CH + kk * 32 + fq * 8);
        const GAS v4u* ur = (const GAS v4u*)(Z + (size_t)(r0 + t) * DIN + h * HD + 8 * fq);
        v4u uu[4];
#pragma unroll
        for (int p = 0; p < 4; ++p) uu[p] = ur[4 * p];
        const float bias = b_sp[h * CH + t];
        {   float v[32]; float ss = 0.f;
#pragma unroll
            for (int i = 0; i < 4; ++i) { v[8 * i + 0] = bf_lo(vw[i].x); v[8 * i + 1] = bf_hi(vw[i].x); v[8 * i + 2] = bf_lo(vw[i].y); v[8 * i + 3] = bf_hi(vw[i].y);
                v[8 * i + 4] = bf_lo(vw[i].z); v[8 * i + 5] = bf_hi(vw[i].z); v[8 * i + 6] = bf_lo(vw[i].w); v[8 * i + 7] = bf_hi(vw[i].w); }
#pragma unroll
            for (int j = 0; j < 32; ++j) ss += v[j] * v[j];
            ss += __shfl_xor(ss, 1); ss += __shfl_xor(ss, 2);
            const float r = 1.0f / sqrtf(ss * (1.f / HD) + EPS);
            const GAS f32x4* vn = (const GAS f32x4*)(v_norm + h * HD + q * 32);
#pragma unroll
            for (int j4 = 0; j4 < 8; ++j4) { const f32x4 gn = vn[j4];
                vT[(q * 32 + 4 * j4 + 0) * VS + s] = (bf16)f2bf(v[4 * j4 + 0] * r * gn.x); vT[(q * 32 + 4 * j4 + 1) * VS + s] = (bf16)f2bf(v[4 * j4 + 1] * r * gn.y);
                vT[(q * 32 + 4 * j4 + 2) * VS + s] = (bf16)f2bf(v[4 * j4 + 2] * r * gn.z); vT[(q * 32 + 4 * j4 + 3) * VS + s] = (bf16)f2bf(v[4 * j4 + 3] * r * gn.w); }
        }
        LDS_WAIT(); __syncthreads();
        if (ui + 1 < u1) { const int un = ui + 1; const GAS v4u* src = (const GAS v4u*)(Z + (size_t)((un / NH) * CH + s) * DIN + DA + (un % NH) * HD + q * 32);
#pragma unroll
            for (int i = 0; i < 4; ++i) vw[i] = src[i]; }
        f32x4 acc[8];
#pragma unroll
        for (int n = 0; n < 8; ++n) { acc[n] = (f32x4){0.f, 0.f, 0.f, 0.f};
#pragma unroll
            for (int kk = 0; kk < 4; ++kk) { const bf16x8 bfr = *(const LAS bf16x8*)(vT + (32 * (n >> 1) + 8 * (fr >> 2) + 4 * (n & 1) + (fr & 3)) * VS + kk * 32 + fq * 8);
                acc[n] = __builtin_amdgcn_mfma_f32_16x16x32_bf16(bfr, af[kk], acc[n], 0, 0, 0); } }
        GAS v4u* orow = (GAS v4u*)(YCAT + (size_t)(r0 + t) * D + h * HD + 8 * fq);
#pragma unroll
        for (int p = 0; p < 4; ++p) { const v4u w = uu[p]; const f32x4 a0 = acc[2 * p], a1 = acc[2 * p + 1];
            v4u o; o.x = pk2(bf_lo(w.x) * (a0[0] + bias), bf_hi(w.x) * (a0[1] + bias)); o.y = pk2(bf_lo(w.y) * (a0[2] + bias), bf_hi(w.y) * (a0[3] + bias));
            o.z = pk2(bf_lo(w.z) * (a1[0] + bias), bf_hi(w.z) * (a1[1] + bias)); o.w = pk2(bf_lo(w.w) * (a1[2] + bias), bf_hi(w.w) * (a1[3] + bias));
            orow[4 * p] = o; }
    }
    LDS_WAIT(); __syncthreads();
}

__device__ __forceinline__ void acc8(float (&S)[8], const v4u w, float sgn) {
    S[0] += sgn * bf_lo(w.x); S[1] += sgn * bf_hi(w.x); S[2] += sgn * bf_lo(w.y); S[3] += sgn * bf_hi(w.y); S[4] += sgn * bf_lo(w.z); S[5] += sgn * bf_hi(w.z); S[6] += sgn * bf_lo(w.w); S[7] += sgn * bf_hi(w.w); }
template <int HW>
__device__ __forceinline__ void pool_strip8(const bf16* Z, bf16* PB, int strip, int cg) {
    const int m0 = strip * 8;
    const int s0 = (m0 < M_PROMPT) ? (m0 & ~(SEQ_P - 1)) : (M_PROMPT + ((m0 - M_PROMPT) & ~(SEQ_S - 1)));
    const int len = (m0 < M_PROMPT) ? SEQ_P : SEQ_S, t0 = m0 - s0;
    const bf16* zc = Z + (size_t)s0 * DIN + 2 * DA + 8 * cg;
    constexpr int NR = 2 * HW + 7;
    v4u r[NR];
#pragma unroll
    for (int j = 0; j < NR; ++j) { const int t = t0 - HW + j; r[j] = (v4u){0u, 0u, 0u, 0u}; if (t >= 0 && t < len) r[j] = *(const GAS v4u*)(zc + (size_t)t * DIN); }
    float S[8];
#pragma unroll
    for (int i = 0; i < 8; ++i) S[i] = 0.f;
#pragma unroll
    for (int j = 0; j < 2 * HW; ++j) acc8(S, r[j], 1.0f);
#pragma unroll
    for (int i = 0; i < 8; ++i) { const int t = t0 + i;
        const int lo = (t - HW) > 0 ? (t - HW) : 0, hi = (t + HW) < len ? (t + HW) : len;
        const float inv = 1.0f / (float)(hi - lo); const v4u w = r[i + HW];
        v4u o; o.x = pk2(S[0] * inv - bf_lo(w.x), S[1] * inv - bf_hi(w.x)); o.y = pk2(S[2] * inv - bf_lo(w.y), S[3] * inv - bf_hi(w.y));
        o.z = pk2(S[4] * inv - bf_lo(w.z), S[5] * inv - bf_hi(w.z)); o.w = pk2(S[6] * inv - bf_lo(w.w), S[7] * inv - bf_hi(w.w));
        *(GAS v4u*)(PB + (size_t)(s0 + t) * DB + 8 * cg) = o;
        if (i < 7) { acc8(S, r[i + 2 * HW], 1.0f); acc8(S, r[i], -1.0f); } }
}

struct Args { const float* in[22]; float* out; unsigned char* ws; int ph_lo, ph_hi; };
__global__ void __launch_bounds__(NWAVES * 64, 2) mk_fwd(Args args) {
    extern __shared__ __attribute__((aligned(16))) unsigned char lds[];
    Frame F;
    F.lds = (LAS unsigned char*)lds;
    F.MISC = (volatile LAS unsigned*)(F.lds + MISC_OFF);
    F.tid = threadIdx.x; F.lane = F.tid & 63; F.wave = __builtin_amdgcn_readfirstlane(F.tid >> 6);
    F.G = gridDim.x; { const int bx = blockIdx.x; F.vcu = (F.G % 8 == 0) ? (bx % 8) * (F.G / 8) + bx / 8 : bx; }
    unsigned char* ws = args.ws;
    F.ctl = (gu32*)(ws + WS_CTL);
    for (int u = F.tid; u < (LDS_BYTES - LDSCTL_OFF) / 4; u += NWAVES * 64) ((LAS unsigned*)(F.lds + LDSCTL_OFF))[u] = 0u;
    __syncthreads();
    XcdBarrier bar; bar.bar = (unsigned*)(F.ctl + CW_BAR); bar.x = 0; bar.st = nullptr;
    if (N_LAUNCHES == 1) bar = xcd_barrier_post((unsigned*)(F.ctl + CW_BAR), F.MISC + 8);
    volatile LAS unsigned long long* pr = (volatile LAS unsigned long long*)(F.lds + LDSX_OFF + 3072);
    if (PROBE != 0 && F.tid == 0) { pr[0] = 0ull; pr[1] = 0ull; pr[2] = __builtin_amdgcn_s_memrealtime(); }
#define PR_SET() do { if (F.tid == 0) pr[0] = __builtin_amdgcn_s_memrealtime(); } while (0)
#define PR_DIFF() do { if (F.tid == 0) pr[0] = __builtin_amdgcn_s_memrealtime() - pr[0]; } while (0)
    int pr_seam = 0;
#define GRID_BAR() do { if (N_LAUNCHES == 1) { const bool _m = (PROBE == 6) || (PROBE == 12 && pr_seam == PROBE_PH); if (_m && F.tid == 0) pr[3] = __builtin_amdgcn_s_memrealtime(); xcd_barrier(bar); if (_m && F.tid == 0) pr[1] += __builtin_amdgcn_s_memrealtime() - pr[3]; ++pr_seam; } } while (0)

    const float* x_p = args.in[0]; const float* x_s = args.in[1];
    signed char* WGU1 = (signed char*)(ws + WS_WGU1); bf16* WD1 = (bf16*)(ws + WS_WD1); signed char* WGU2 = (signed char*)(ws + WS_WGU2); bf16* WD2 = (bf16*)(ws + WS_WD2);
    bf16* WIN = (bf16*)(ws + WS_WIN); bf16* WOUT = (bf16*)(ws + WS_WOUT); bf16* WSP = (bf16*)(ws + WS_WSP); bf16* WPT = (bf16*)(ws + WS_WPT);
    bf16* AB = (bf16*)(ws + WS_A); signed char* AQ = (signed char*)(ws + WS_A); bf16* PB = (bf16*)(ws + WS_A);
    bf16* HID = (bf16*)(ws + WS_HID); bf16* ZB = (bf16*)(ws + WS_Z); bf16* YCAT = (bf16*)(ws + WS_YCAT); bf16* YB = (bf16*)(ws + WS_Y);
    float* STATS = (float*)(ws + WS_STATS); float* SA = (float*)(ws + WS_SA); float* SW1 = (float*)(ws + WS_SW1); float* SW2 = (float*)(ws + WS_SW2);
    float* H = args.out;

    const int lo = args.ph_lo, hi = args.ph_hi;
#define IN(k) (lo <= (k) && (k) < hi)
#define BOTH(k) (IN(k) && IN((k) == 0 ? 2 : (k) + 1))

    LAS float* const scr = (LAS float*)(F.lds + RING_OFF + F.wave * 16384);
    LAS float* const cmx = (LAS float*)(F.lds + LDSX_OFF);
    volatile LAS unsigned* const tkt = (volatile LAS unsigned*)(F.lds + LDSX_OFF + 2048);
    const int lane = F.lane;
    constexpr int NCBLK = FF / 32;
    auto gu_job = [&](const int mat, const int n0, const int jpar) __attribute__((always_inline)) {
            const float* W = args.in[mat == 0 ? 4 : mat == 1 ? 5 : mat == 2 ? 18 : 19];
            const int c4 = lane & 7, krow0 = F.wave * 512 + (lane >> 3) * 64;
            const GAS f32x4* p = (const GAS f32x4*)(W + (size_t)krow0 * FF + n0) + c4;
            v2u d[64]; float m0 = 0.f, m1 = 0.f, m2 = 0.f, m3 = 0.f;
#pragma unroll
            for (int ib = 0; ib < 4; ++ib) {
                f32x4 v[16];
#pragma unroll
                for (int i = 0; i < 16; ++i) v[i] = __builtin_nontemporal_load(&p[(size_t)(16 * ib + i) * (FF / 4)]);
                __builtin_amdgcn_sched_barrier(0);
#pragma unroll
                for (int i = 0; i < 16; ++i) { m0 = fmaxf(m0, fabsf(v[i].x)); m1 = fmaxf(m1, fabsf(v[i].y)); m2 = fmaxf(m2, fabsf(v[i].z)); m3 = fmaxf(m3, fabsf(v[i].w));
                    d[16 * ib + i].x = pg8::cvt_pk_bf16(v[i].x, v[i].y); d[16 * ib + i].y = pg8::cvt_pk_bf16(v[i].z, v[i].w); }
                __builtin_amdgcn_sched_barrier(0);
            }
#pragma unroll
            for (int o = 8; o < 64; o <<= 1) { m0 = fmaxf(m0, __shfl_xor(m0, o)); m1 = fmaxf(m1, __shfl_xor(m1, o)); m2 = fmaxf(m2, __shfl_xor(m2, o)); m3 = fmaxf(m3, __shfl_xor(m3, o)); }
            if (lane < 8) { LAS float* cw = cmx + (jpar * 8 + F.wave) * 32 + 4 * lane; cw[0] = m0; cw[1] = m1; cw[2] = m2; cw[3] = m3; }
            LDS_WAIT(); __syncthreads();
            f32x4 cm4 = (f32x4){0.f, 0.f, 0.f, 0.f};
#pragma unroll
            for (int w8 = 0; w8 < 8; ++w8) { const f32x4 cv = *(const LAS f32x4*)(cmx + (jpar * 8 + w8) * 32 + 4 * c4); cm4.x = fmaxf(cm4.x, cv.x); cm4.y = fmaxf(cm4.y, cv.y); cm4.z = fmaxf(cm4.z, cv.z); cm4.w = fmaxf(cm4.w, cv.w); }
            const float i0 = cm4.x > 0.f ? 127.0f / cm4.x : 0.f, i1 = cm4.y > 0.f ? 127.0f / cm4.y : 0.f, i2 = cm4.z > 0.f ? 127.0f / cm4.z : 0.f, i3 = cm4.w > 0.f ? 127.0f / cm4.w : 0.f;
            const int drow0 = 256 * (n0 >> 7) + (n0 & 127) + ((mat & 1) ? 128 : 0);
            signed char* WQ = mat < 2 ? WGU1 : WGU2;
            GAS char* q0p = (GAS char*)WQ + (size_t)(drow0 + 4 * c4) * D + krow0;
#pragma unroll
            for (int b = 0; b < 4; ++b) {
                v4u o0, o1, o2, o3;
#pragma unroll
                for (int a = 0; a < 4; ++a) { const v2u r0 = d[16 * b + 4 * a + 0], r1 = d[16 * b + 4 * a + 1], r2 = d[16 * b + 4 * a + 2], r3 = d[16 * b + 4 * a + 3];
                    o0[a] = pk4q(bf_lo(r0.x) * i0, bf_lo(r1.x) * i0, bf_lo(r2.x) * i0, bf_lo(r3.x) * i0); o1[a] = pk4q(bf_hi(r0.x) * i1, bf_hi(r1.x) * i1, bf_hi(r2.x) * i1, bf_hi(r3.x) * i1);
                    o2[a] = pk4q(bf_lo(r0.y) * i2, bf_lo(r1.y) * i2, bf_lo(r2.y) * i2, bf_lo(r3.y) * i2); o3[a] = pk4q(bf_hi(r0.y) * i3, bf_hi(r1.y) * i3, bf_hi(r2.y) * i3, bf_hi(r3.y) * i3); }
                *(GAS v4u*)(q0p + 0 * D + 16 * b) = o0; *(GAS v4u*)(q0p + 1 * D + 16 * b) = o1; *(GAS v4u*)(q0p + 2 * D + 16 * b) = o2; *(GAS v4u*)(q0p + 3 * D + 16 * b) = o3; }
            if (F.wave == 0 && lane < 8) { float* swp = (mat < 2 ? SW1 : SW2) + drow0 + 4 * c4;
                swp[0] = cm4.x > 0.f ? cm4.x * (1.0f / 127.0f) : 1.0f; swp[1] = cm4.y > 0.f ? cm4.y * (1.0f / 127.0f) : 1.0f; swp[2] = cm4.z > 0.f ? cm4.z * (1.0f / 127.0f) : 1.0f; swp[3] = cm4.w > 0.f ? cm4.w * (1.0f / 127.0f) : 1.0f; }
    };
    constexpr int I_D = (FF / 64) * (D / 32), I_IN = (D / 64) * (DIN / 32), I_OUT = (D / 64) * (D / 32), I_P = (DPG / 64) * (DPG / 32);
    constexpr int NITEMS = 2 * I_D + I_IN + I_OUT + 4 * I_P, NCT = NITEMS / 32, NCX = M / 32;
    constexpr int NC_D2 = I_D / 32;
    static_assert(I_D % 32 == 0, "WD2 chunks");
    constexpr int NCT1 = NCT - (WD2_IN_P10 ? NC_D2 : 0);
    static_assert(NITEMS % 32 == 0 && M % 32 == 0 && I_D % 4 == 0 && I_IN % 4 == 0 && I_OUT % 4 == 0 && I_P % 4 == 0, "queue chunks");
    auto tr_chunk = [&](const int cur) __attribute__((always_inline)) {
        int r = (cur * 8 + F.wave) * 4;
        TJob J;
        if (r < I_D) J = TJob{args.in[6], WD1, FF, D, 0, 1, nullptr};
        else if ((r -= I_D) < I_IN) J = TJob{args.in[9], WIN, D, DIN, 0, 0, args.in[7]};
        else if ((r -= I_IN) < I_OUT) J = TJob{args.in[15], WOUT, D, D, 0, 0, nullptr};
        else if ((r -= I_OUT) < 4 * I_P) { const int gp = r / I_P; J = TJob{args.in[13] + (size_t)gp * DPG * DPG, WPT, DPG, DPG, gp * DPG, 0, nullptr}; r -= gp * I_P; }
        else { r -= 4 * I_P; J = TJob{args.in[20], WD2, FF, D, 0, 1, nullptr}; }
#pragma unroll
        for (int i = 0; i < 4; i += 2) { f32x4 va[8], vb[8];
            tr_load(J, r + i, lane, va); tr_load(J, r + i + 1, lane, vb);
            __builtin_amdgcn_sched_barrier(0);
            tr_commit(J, r + i, lane, va, scr); tr_commit(J, r + i + 1, lane, vb, scr); }
    };
    if (IN(0)) { if (PROBE == 11 && PROBE_PH == 0) PR_SET();
        constexpr int NJOBS = (BG_IN_P2 ? 2 : 4) * NCBLK;
        int jpar = 0;
        for (int job = F.vcu; job < NJOBS; job += F.G, jpar ^= 1) gu_job(job / NCBLK, (job % NCBLK) * 32, jpar);
        for (int i = (blockIdx.x * NWAVES * 64 + F.tid); i < NH * CH * CH / 4; i += F.G * NWAVES * 64) {
            const f32x4 v = ((const GAS f32x4*)args.in[10])[i]; v2u w; w.x = pk2(v.x, v.y); w.y = pk2(v.z, v.w); ((GAS v2u*)WSP)[i] = w; }
        constexpr int NT0 = (BG_IN_P2 && BG_TR) ? 0 : NCT1, NCHUNK = NT0 + NCX;
        unsigned* qhead = (unsigned*)(F.ctl + CW_QUEUE);
        unsigned nxt = 0u; int tpar = 0;
        if (F.tid == 0) nxt = __hip_atomic_fetch_add(qhead, 1u, RLX_AGENT);
        for (;;) {
            if (F.tid == 0) tkt[tpar] = nxt;
            LDS_WAIT(); __syncthreads();
            const unsigned cur = tkt[tpar]; tpar ^= 1;
            if (cur >= (unsigned)NCHUNK) break;
            if (F.tid == 0) nxt = __hip_atomic_fetch_add(qhead, 1u, RLX_AGENT);
            if (cur < (unsigned)NT0) tr_chunk((int)cur);
            else { for (int i = 0; i < 4; ++i) { const int m = (((int)cur - NT0) * 8 + F.wave) * 4 + i; rms_row_to_q(lane, x_row(x_p, x_s, m), args.in[2], AQ + (size_t)m * D, SA + m); } }
        }
        if (BOTH(0)) GRID_BAR();
        if (PROBE == 11 && PROBE_PH == 0) PR_DIFF();
        if (PROBE == 9) do { if (F.tid == 0) pr[0] = __builtin_amdgcn_s_memrealtime() - pr[2]; } while (0);
    }
    if (IN(2)) { if (PROBE == 11 && PROBE_PH == 2) PR_SET();
        const int GG = BG_IN_P2 ? F.G - NBG : F.G;
        if ((int)blockIdx.x < GG) {
            pg8::Gemm g = pg8::gemm_rm(AQ, WGU1, D, D, D); pg8::StaticOrder S; S.init(M, NGU, GG, (int)blockIdx.x, WGM_GU);
            pg8::EpiSwiGLUQ E{HID, FF, SA, SW1};
            pg8::gemm_phase<pg8::EpiSwiGLUQ, pg8::StaticOrder, true>(F.lds + RING_OFF, g, S, E);
        }
        if (BG_IN_P2) {
            constexpr int NJ2 = 2 * NCBLK, NTK = NJ2 + (BG_TR ? NCT1 : 0);
            unsigned* qhead = (unsigned*)(F.ctl + CW_QUEUE2);
            unsigned nxt = 0u; int tpar = 0, jpar = 0;
            if (F.tid == 0) nxt = __hip_atomic_fetch_add(qhead, 1u, RLX_AGENT);
            for (;;) {
                if (F.tid == 0) tkt[tpar] = nxt;
                LDS_WAIT(); __syncthreads();
                const unsigned cur = tkt[tpar]; tpar ^= 1;
                if (cur >= (unsigned)NTK) break;
                if (F.tid == 0) nxt = __hip_atomic_fetch_add(qhead, 1u, RLX_AGENT);
                if (cur < (unsigned)NJ2) { gu_job(2 + (int)cur / NCBLK, ((int)cur % NCBLK) * 32, jpar); jpar ^= 1; }
                else tr_chunk((int)cur - NJ2);
            }
        }
        if (BOTH(2)) GRID_BAR();
        if (PROBE == 11 && PROBE_PH == 2) PR_DIFF();
    }
    if (IN(3)) { if (PROBE == 11 && PROBE_PH == 3) PR_SET();
        pg8::Gemm g = pg8::gemm_tiled(HID, WD1, FF * 2); pg8::StaticOrder S; S.init(M, D, F.G, (int)blockIdx.x, WGM_DOWN, REV_DOWN);
        pg8::EpiYStats E{YB, D, STATS};
        pg8::gemm_phase<pg8::EpiYStats, pg8::StaticOrder, true>(F.lds + RING_OFF, g, S, E);
        if (BOTH(3)) GRID_BAR();
        if (PROBE == 11 && PROBE_PH == 3) PR_DIFF();
    }
    if (IN(4)) { if (PROBE == 11 && PROBE_PH == 4) PR_SET();
        norm_phase<0, true, 0>(F, x_p, x_s, YB, STATS, 0.5f, args.in[3], args.in[7], H, nullptr, nullptr, SA);
        if (BOTH(4)) GRID_BAR();
        if (PROBE == 11 && PROBE_PH == 4) PR_DIFF();
    }
    if (IN(5)) { if (PROBE == 11 && PROBE_PH == 5) PR_SET();
        pg8::Gemm g = pg8::gemm_rm((const char*)H + D * 2, WIN, D * 4, D * 2, D * 2);   pg8::MixOrder S; S.init(M, DIN, F.G, (int)blockIdx.x, 4, 1);
        pg8::EpiZ E{ZB, DIN, (2 * DA) / 256, SA};
        pg8::gemm_phase<pg8::EpiZ, pg8::MixOrder, true>(F.lds + RING_OFF, g, S, E);
        if (BOTH(5)) GRID_BAR();
        if (PROBE == 11 && PROBE_PH == 5) PR_DIFF();
    }
    if (IN(6)) { if (PROBE == 11 && PROBE_PH == 6) PR_SET();
        constexpr int NUNITS = (M / CH) * NH;
        const int per = (NUNITS + F.G - 1) / F.G;
        { const int ua = F.vcu * per, ub = (ua + per) < NUNITS ? (ua + per) : NUNITS; spatial_units(F, ua, ub, ZB, WSP, args.in[11], args.in[12], YCAT); }
        constexpr int NSTRIPS = M / 8;
        for (int sp = F.vcu * 2 + (F.tid >> 8); sp < NSTRIPS; sp += F.G * 2) { const int cg = F.tid & 255;
            switch (cg >> 6) { case 0: pool_strip8<1>(ZB, PB, sp, cg); break; case 1: pool_strip8<2>(ZB, PB, sp, cg); break; case 2: pool_strip8<4>(ZB, PB, sp, cg); break; default: pool_strip8<8>(ZB, PB, sp, cg); break; } }
        if (BOTH(6)) GRID_BAR();
        if (PROBE == 11 && PROBE_PH == 6) PR_DIFF();
    }
    if (IN(7)) { if (PROBE == 11 && PROBE_PH == 7) PR_SET();
        pg8::Gemm g = pg8::gemm_rm(PB, WPT, DB * 2, DPG * 2, DPG * 2, DPG * 2); pg8::StaticOrder S; S.init(M, DB, F.G, (int)blockIdx.x);
        pg8::EpiScale E{YCAT, D, DA, args.in[14]};
        pg8::gemm_phase<pg8::EpiScale, pg8::StaticOrder, true>(F.lds + RING_OFF, g, S, E);
        if (BOTH(7)) GRID_BAR();
        if (PROBE == 11 && PROBE_PH == 7) PR_DIFF();
    }
    if (IN(8)) { if (PROBE == 11 && PROBE_PH == 8) PR_SET();
        pg8::Gemm g = pg8::gemm_rm(YCAT, WOUT, D * 2, D * 2, D * 2); pg8::StaticOrder S; S.init(M, D, F.G, (int)blockIdx.x, 4);
        pg8::EpiYStats E{YB, D, STATS};
        pg8::gemm_phase<pg8::EpiYStats, pg8::StaticOrder, true>(F.lds + RING_OFF, g, S, E);
        if (BOTH(8)) GRID_BAR();
        if (PROBE == 11 && PROBE_PH == 8) PR_DIFF();
    }
    if (IN(9)) { if (PROBE == 11 && PROBE_PH == 9) PR_SET();
        norm_phase<2, false, 1>(F, nullptr, nullptr, YB, STATS, 1.0f, args.in[8], args.in[16], H, nullptr, AQ, SA);
        if (BOTH(9)) GRID_BAR();
        if (PROBE == 11 && PROBE_PH == 9) PR_DIFF();
    }
    if (IN(10)) { if (PROBE == 11 && PROBE_PH == 10) PR_SET();
        pg8::Gemm g = pg8::gemm_rm(AQ, WGU2, D, D, D); pg8::StaticOrder S; S.init(M, NGU, F.G, (int)blockIdx.x, WGM_GU);
        pg8::EpiSwiGLUQ E{HID, FF, SA, SW2};
        pg8::gemm_phase<pg8::EpiSwiGLUQ, pg8::StaticOrder, true>(F.lds + RING_OFF, g, S, E);
        if (WD2_IN_P10) {
            unsigned* qhead = (unsigned*)(F.ctl + CW_QUEUE3);
            unsigned nxt = 0u; int tpar = 0;
            if (F.tid == 0) nxt = __hip_atomic_fetch_add(qhead, 1u, RLX_AGENT);
            for (;;) {
                if (F.tid == 0) tkt[tpar] = nxt;
                LDS_WAIT(); __syncthreads();
                const unsigned cur = tkt[tpar]; tpar ^= 1;
                if (cur >= (unsigned)NC_D2) break;
                if (F.tid == 0) nxt = __hip_atomic_fetch_add(qhead, 1u, RLX_AGENT);
                tr_chunk(NCT - NC_D2 + (int)cur);
            }
        }
        if (BOTH(10)) GRID_BAR();
        if (PROBE == 11 && PROBE_PH == 10) PR_DIFF();
    }
    if (IN(11)) { if (PROBE == 11 && PROBE_PH == 11) PR_SET();
        pg8::Gemm g = pg8::gemm_tiled(HID, WD2, FF * 2); pg8::StaticOrder S; S.init(M, D, F.G, (int)blockIdx.x, WGM_DOWN, REV_DOWN);
        pg8::EpiYStats E{YB, D, STATS};
        pg8::gemm_phase<pg8::EpiYStats, pg8::StaticOrder, true>(F.lds + RING_OFF, g, S, E);
        if (BOTH(11)) GRID_BAR();
        if (PROBE == 11 && PROBE_PH == 11) PR_DIFF();
    }
    if (IN(12)) { if (PROBE == 11 && PROBE_PH == 12) PR_SET();
        norm_phase<1, false, 0>(F, nullptr, nullptr, YB, STATS, 0.5f, args.in[17], args.in[21], H, nullptr, nullptr, nullptr);
    }
    if (PROBE == 9 || PROBE == 10 || PROBE == 11) {
        GRID_BAR();
        if (blockIdx.x == 0 && F.tid == 0) { const unsigned long long t0 = __builtin_amdgcn_s_memrealtime(); const unsigned long long pm = pr[0]; const unsigned long long lim = pm < 500000ull ? pm : 500000ull; while (__builtin_amdgcn_s_memrealtime() - t0 < lim) __builtin_amdgcn_s_sleep(8); }
    }
    if (PROBE == 6 || PROBE == 12) {
        if (F.tid == 0) atomicAdd((unsigned long long*)(F.ctl + CW_PROBE), (unsigned long long)pr[1]);
        GRID_BAR();
        if (blockIdx.x == 0 && F.tid == 0) { const unsigned long long tot = __hip_atomic_load((unsigned long long*)(F.ctl + CW_PROBE), RLX_AGENT) / (unsigned long long)F.G;
            const unsigned long long t0 = __builtin_amdgcn_s_memrealtime(); const unsigned long long lim = tot < 500000ull ? tot : 500000ull; while (__builtin_amdgcn_s_memrealtime() - t0 < lim) __builtin_amdgcn_s_sleep(8); }
    }
#undef IN
#undef BOTH
#undef GRID_BAR
}

extern "C" void kernel_launch(void* const* d_in, const int* in_sizes, int n_in, void* d_out, int out_size, void* d_ws, size_t ws_size, hipStream_t stream) {
    static int grid = 0;
    if (grid == 0) {
        if (n_in != 22 || in_sizes[0] != M_PROMPT * D || out_size != M * D || ws_size < WS_END) {
            fprintf(stderr, "kernel_launch: shape/workspace mismatch: n_in %d in0 %d out %d ws %zu (need %zu); nothing launched\n", n_in, n_in > 0 ? in_sizes[0] : -1, out_size, ws_size, (size_t)WS_END); grid = -1; return; }
        int dev = 0, cus = 0, per_cu = 0;
        if (hipGetDevice(&dev) != hipSuccess || hipDeviceGetAttribute(&cus, hipDeviceAttributeMultiprocessorCount, dev) != hipSuccess) { fprintf(stderr, "kernel_launch: device query failed\n"); grid = -1; return; }
        if (hipFuncSetAttribute((const void*)mk_fwd, hipFuncAttributeMaxDynamicSharedMemorySize, LDS_BYTES) != hipSuccess) { fprintf(stderr, "kernel_launch: hipFuncSetAttribute failed\n"); grid = -1; return; }
        if (hipOccupancyMaxActiveBlocksPerMultiprocessor(&per_cu, (const void*)mk_fwd, NWAVES * 64, LDS_BYTES) != hipSuccess || per_cu < 1) {
            fprintf(stderr, "kernel_launch: occupancy query reports %d workgroups per CU\n", per_cu); }
        (void)hipGetLastError();
        grid = cus;
    }
    if (grid < 0) return;
    if (hipMemsetAsync((char*)d_ws + WS_CTL, 0, CTL_ZERO_BYTES, stream) != hipSuccess) { fprintf(stderr, "kernel_launch: memset failed\n"); return; }
    Args a{};
    for (int i = 0; i < 22; ++i) a.in[i] = (const float*)d_in[i];
    a.out = (float*)d_out; a.ws = (unsigned char*)d_ws;
    if (N_LAUNCHES == 1) { a.ph_lo = 0; a.ph_hi = N_PHASES; hipLaunchKernelGGL(mk_fwd, dim3(grid), dim3(NWAVES * 64), LDS_BYTES, stream, a); }
    else for (int li = 0; li < N_PHASES; ++li) { a.ph_lo = li; a.ph_hi = li + 1; hipLaunchKernelGGL(mk_fwd, dim3(grid), dim3(NWAVES * 64), LDS_BYTES, stream, a); }
    const hipError_t le = hipPeekAtLastError();
    if (le != hipSuccess) fprintf(stderr, "kernel_launch: launch failed: %s\n", hipGetErrorName(le));
}
```

```cpp
#include <hip/hip_runtime.h>
#include <cstdio>
#include <cstdint>

namespace pg8 {
#define PG8_LAS __attribute__((address_space(3)))
typedef unsigned short bf16_t;
typedef short bf16x8 __attribute__((ext_vector_type(8)));
typedef float f32x4 __attribute__((ext_vector_type(4)));
typedef float f32x2 __attribute__((ext_vector_type(2)));
typedef unsigned u32x4 __attribute__((ext_vector_type(4)));
typedef unsigned u32x2 __attribute__((ext_vector_type(2)));
typedef int i32x4 __attribute__((ext_vector_type(4)));
constexpr int BM = 256, BK = 64, HALF = 128, HTB = HALF * BK * 2  , STAGE_BYTES = 8 * HTB, NXCD = 8, WGM = 8;

__host__ __device__ __forceinline__ int lds_byte(int r, int c) { const int st = (r >> 4) * 2 + (c >> 5), rr = r & 15, cc = c & 31, ob = rr * 64 + cc * 2; return st * 1024 + (ob ^ (((ob >> 9) & 1) << 5)); }
__host__ __device__ __forceinline__ void stage_rc(int b, int& R, int& C) { const int st = b / 1024, sb = b % 1024, swz = sb ^ (((sb >> 9) & 1) << 5); R = (st >> 1) * 16 + swz / 64; C = (st & 1) * 32 + (swz % 64) / 2; }
__host__ __device__ __forceinline__ int perm32(int rho) { const int n = rho >> 4, i = rho & 15; return 8 * (i >> 2) + 4 * n + (i & 3); }

struct Unit { int pm, pn; };
struct Gemm { const void* A; const void* Bt; int ldaB, ldbB, KB, a_cbytes, kstepA, kstepB; size_t tstepA, tstepB; };
__host__ __device__ __forceinline__ Gemm gemm_rm(const void* A, const void* Bt, int ldaB, int ldbB, int KB, int a_cbytes = 0) { return Gemm{A, Bt, ldaB, ldbB, KB, a_cbytes, 128, 128, (size_t)256 * ldaB, (size_t)256 * ldbB}; }
constexpr int TILE_BYTES = 32768;
__host__ __device__ __forceinline__ Gemm gemm_tiled(const void* A, const void* Bt, int KB) { return Gemm{A, Bt, 128, 128, KB, 0, TILE_BYTES, TILE_BYTES, (size_t)256 * KB, (size_t)256 * KB}; }

struct StaticOrder {
    int nM, nN, nwg, G, c, wgm, rev;
    __host__ __device__ void init(int M, int N, int G_, int c_, int wgm_ = WGM, int rev_ = 0) { nM = M / BM; nN = N / BM; nwg = nM * nN; G = G_; c = c_; wgm = wgm_; rev = rev_; }
    __host__ __device__ bool next(int i, Unit& u) const {
        const long L = (long)i * G + c; if (L >= nwg) return false;
        int wgid = (int)L; { const int q = nwg / NXCD, r = nwg % NXCD, xcd = wgid % NXCD, cnt = xcd < r ? q + 1 : q; int off = wgid / NXCD; if (rev) off = cnt - 1 - off; wgid = (xcd < r ? xcd * (q + 1) : r * (q + 1) + (xcd - r) * q) + off; }
        const int nig = wgm * nN, gid = wgid / nig, fm = gid * wgm, gsz = (nM - fm) < wgm ? (nM - fm) : wgm;
        u.pm = fm + ((wgid % nig) % gsz); u.pn = (wgid % nig) / gsz; return true;
    }
    __device__ __forceinline__ void a_ready(const Unit&) const {}
    __device__ __forceinline__ void done(const Unit&) const {}
};

struct MixOrder : StaticOrder {
    __device__ bool next(int i, Unit& u) const { if (!StaticOrder::next(i, u)) return false; const int p = u.pn, q = p / 3, r = p - 3 * q; u.pn = (r < 2) ? 2 * q + r : 16 + q; return true; }
};
__device__ __forceinline__ unsigned cvt_pk_bf16(float lo, float hi) { unsigned r; asm volatile("v_cvt_pk_bf16_f32 %0, %1, %2" : "=v"(r) : "v"(lo), "v"(hi)); return r; }
__device__ __forceinline__ f32x2 gelu_pk(f32x2 v) {
    const f32x2 av = __builtin_elementwise_abs(v), d = av * 0.2316418882f + 1.0f;
    f32x2 t; t.x = __builtin_amdgcn_rcpf(d.x); t.y = __builtin_amdgcn_rcpf(d.y);
    f32x2 q = t * 0.5307027145f + (-0.7265760135f); q = q * t + 0.7107068705f; q = q * t + (-0.142248368f); q = q * t + 0.127414796f; q = q * t;
    const f32x2 s = (v * v) * (-0.72134752044f);
    f32x2 e; e.x = __builtin_amdgcn_exp2f(s.x); e.y = __builtin_amdgcn_exp2f(s.y);
    const f32x2 m = v * (q * e), r = v - m;
    f32x2 o; o.x = v.x < 0.f ? m.x : r.x; o.y = v.y < 0.f ? m.y : r.y; return o;
}
__device__ __forceinline__ float silu_f(float g) { return g * __builtin_amdgcn_rcpf(1.0f + __builtin_amdgcn_exp2f(-1.44269504f * g)); }

struct EpiSwiGLU {
    static constexpr bool PERM = true, AFTER_DRAIN = false, I8 = false; typedef f32x4 acc_t;
    bf16_t* O; int ldc;
    __device__ __forceinline__ void operator()(const f32x4 (&acc)[2][2][4][2], const Unit& u, int wr, int wc, int fr, int fq) const {
        const int row0 = u.pm * BM + wr * 64 + fr, col0 = u.pn * HALF + wc * 32 + 8 * fq;
#pragma unroll
        for (int ai = 0; ai < 2; ++ai)
#pragma unroll
            for (int m = 0; m < 4; ++m) { bf16_t* rowp = O + (size_t)(row0 + ai * HALF + m * 16) * ldc + col0;
                const f32x4 g0 = acc[ai][0][m][0], g1 = acc[ai][0][m][1], u0 = acc[ai][1][m][0], u1 = acc[ai][1][m][1];
                u32x4 w;
                w.x = cvt_pk_bf16(silu_f(g0[0]) * u0[0], silu_f(g0[1]) * u0[1]); w.y = cvt_pk_bf16(silu_f(g0[2]) * u0[2], silu_f(g0[3]) * u0[3]);
                w.z = cvt_pk_bf16(silu_f(g1[0]) * u1[0], silu_f(g1[1]) * u1[1]); w.w = cvt_pk_bf16(silu_f(g1[2]) * u1[2], silu_f(g1[3]) * u1[3]);
                *(u32x4*)rowp = w; }
    }
};
struct EpiSwiGLUQ {
    static constexpr bool PERM = true, AFTER_DRAIN = false, I8 = true; typedef i32x4 acc_t;
    bf16_t* O; int ldc; const float* sa; const float* sw;
    __device__ __forceinline__ static f32x4 act4(const i32x4 G, const i32x4 U, const f32x4 kL, const f32x4 kP) {
        const f32x4 gf = __builtin_convertvector(G, f32x4), uf = __builtin_convertvector(U, f32x4);
        const f32x4 t = gf * kL; f32x4 d;
        d.x = __builtin_amdgcn_exp2f(t.x); d.y = __builtin_amdgcn_exp2f(t.y); d.z = __builtin_amdgcn_exp2f(t.z); d.w = __builtin_amdgcn_exp2f(t.w);
        d = d + 1.0f; f32x4 r;
        r.x = __builtin_amdgcn_rcpf(d.x); r.y = __builtin_amdgcn_rcpf(d.y); r.z = __builtin_amdgcn_rcpf(d.z); r.w = __builtin_amdgcn_rcpf(d.w);
        return ((gf * uf) * kP) * r;
    }
    __device__ __forceinline__ void operator()(const i32x4 (&acc)[2][2][4][2], const Unit& u, int wr, int wc, int fr, int fq) const {
        const int row0 = u.pm * BM + wr * 64 + fr;
        const float* swp = sw + u.pn * BM + wc * 32 + 8 * fq;
        const f32x4 sg0 = *(const f32x4*)(swp), sg1 = *(const f32x4*)(swp + 4), su0 = *(const f32x4*)(swp + HALF), su1 = *(const f32x4*)(swp + HALF + 4);
        const f32x4 gu0 = sg0 * su0, gu1 = sg1 * su1;
        float sr[2][4];
#pragma unroll
        for (int ai = 0; ai < 2; ++ai)
#pragma unroll
            for (int m = 0; m < 4; ++m) sr[ai][m] = sa[row0 + ai * HALF + m * 16];
#pragma unroll
        for (int ai = 0; ai < 2; ++ai)
#pragma unroll
            for (int m = 0; m < 4; ++m) { const float s = sr[ai][m];
                bf16_t* rowp = (bf16_t*)((char*)O + ((size_t)u.pm * (ldc / 64) + 2 * u.pn + (wc >> 1)) * TILE_BYTES + (wr * 64 + fr + ai * HALF + m * 16) * 128 + ((wc & 1) * 32 + 8 * fq) * 2);
                const float sl = s * -1.44269504f, ss = s * s;
                const f32x4 o0 = act4(acc[ai][0][m][0], acc[ai][1][m][0], sg0 * sl, gu0 * ss), o1 = act4(acc[ai][0][m][1], acc[ai][1][m][1], sg1 * sl, gu1 * ss);
                u32x4 w; w.x = cvt_pk_bf16(o0[0], o0[1]); w.y = cvt_pk_bf16(o0[2], o0[3]); w.z = cvt_pk_bf16(o1[0], o1[1]); w.w = cvt_pk_bf16(o1[2], o1[3]);
                __builtin_nontemporal_store(w, (u32x4*)rowp); }
    }
};
struct EpiYStats {
    static constexpr bool PERM = true, AFTER_DRAIN = false, I8 = false; typedef f32x4 acc_t;
    bf16_t* O; int ldc; float* stats;
    __device__ __forceinline__ void operator()(const f32x4 (&acc)[2][2][4][2], const Unit& u, int wr, int wc, int fr, int fq) const {
        const int row0 = u.pm * BM + wr * 64 + fr, col0 = u.pn * BM + wc * 32 + 8 * fq;
#pragma unroll
        for (int ai = 0; ai < 2; ++ai)
#pragma unroll
            for (int m = 0; m < 4; ++m) { const int row = row0 + ai * HALF + m * 16; bf16_t* rowp = O + (size_t)row * ldc + col0; float ss = 0.f;
#pragma unroll
                for (int bj = 0; bj < 2; ++bj) { const f32x4 v0 = acc[ai][bj][m][0], v1 = acc[ai][bj][m][1];
                    ss += (v0[0] * v0[0] + v0[1] * v0[1]) + (v0[2] * v0[2] + v0[3] * v0[3]) + (v1[0] * v1[0] + v1[1] * v1[1]) + (v1[2] * v1[2] + v1[3] * v1[3]);
                    u32x4 w; w.x = cvt_pk_bf16(v0[0], v0[1]); w.y = cvt_pk_bf16(v0[2], v0[3]); w.z = cvt_pk_bf16(v1[0], v1[1]); w.w = cvt_pk_bf16(v1[2], v1[3]);
                    *(u32x4*)(rowp + bj * HALF) = w; }
                ss += __shfl_xor(ss, 16); ss += __shfl_xor(ss, 32);
                if (fq == 0) stats[(size_t)row * 64 + u.pn * 4 + wc] = ss; }
    }
};
struct EpiZ {
    static constexpr bool PERM = true, AFTER_DRAIN = false, I8 = false; typedef f32x4 acc_t;
    bf16_t* O; int ldc; int gelu_tiles; const float* rs;
    __device__ __forceinline__ void operator()(const f32x4 (&acc)[2][2][4][2], const Unit& u, int wr, int wc, int fr, int fq) const {
        const int row0 = u.pm * BM + wr * 64 + fr, col0 = u.pn * BM + wc * 32 + 8 * fq; const bool act = u.pn < gelu_tiles;
        float sr[2][4];
#pragma unroll
        for (int ai = 0; ai < 2; ++ai)
#pragma unroll
            for (int m = 0; m < 4; ++m) sr[ai][m] = rs[row0 + ai * HALF + m * 16];
#pragma unroll
        for (int ai = 0; ai < 2; ++ai)
#pragma unroll
            for (int m = 0; m < 4; ++m) { bf16_t* rowp = O + (size_t)(row0 + ai * HALF + m * 16) * ldc + col0; const float s = sr[ai][m];
#pragma unroll
                for (int bj = 0; bj < 2; ++bj) { f32x4 v0 = acc[ai][bj][m][0] * s, v1 = acc[ai][bj][m][1] * s;
                    if (act) { const f32x2 a = gelu_pk((f32x2){v0[0], v0[1]}), b = gelu_pk((f32x2){v0[2], v0[3]}), c = gelu_pk((f32x2){v1[0], v1[1]}), d = gelu_pk((f32x2){v1[2], v1[3]});
                        v0 = (f32x4){a.x, a.y, b.x, b.y}; v1 = (f32x4){c.x, c.y, d.x, d.y}; }
                    u32x4 w; w.x = cvt_pk_bf16(v0[0], v0[1]); w.y = cvt_pk_bf16(v0[2], v0[3]); w.z = cvt_pk_bf16(v1[0], v1[1]); w.w = cvt_pk_bf16(v1[2], v1[3]);
                    *(u32x4*)(rowp + bj * HALF) = w; } }
    }
};
struct EpiScale {
    static constexpr bool PERM = true, AFTER_DRAIN = false, I8 = false; typedef f32x4 acc_t;
    bf16_t* O; int ldc; int ocol; const float* scale;
    __device__ __forceinline__ void operator()(const f32x4 (&acc)[2][2][4][2], const Unit& u, int wr, int wc, int fr, int fq) const {
        const int row0 = u.pm * BM + wr * 64 + fr, col0 = u.pn * BM + wc * 32 + 8 * fq;
        f32x4 sv[2][2];
#pragma unroll
        for (int bj = 0; bj < 2; ++bj)
#pragma unroll
            for (int n = 0; n < 2; ++n) sv[bj][n] = *(const f32x4*)(scale + col0 + bj * HALF + 4 * n);
#pragma unroll
        for (int ai = 0; ai < 2; ++ai)
#pragma unroll
            for (int m = 0; m < 4; ++m) { bf16_t* rowp = O + (size_t)(row0 + ai * HALF + m * 16) * ldc + ocol + col0;
#pragma unroll
                for (int bj = 0; bj < 2; ++bj) { const f32x4 v0 = acc[ai][bj][m][0] * sv[bj][0], v1 = acc[ai][bj][m][1] * sv[bj][1];
                    u32x4 w; w.x = cvt_pk_bf16(v0[0], v0[1]); w.y = cvt_pk_bf16(v0[2], v0[3]); w.z = cvt_pk_bf16(v1[0], v1[1]); w.w = cvt_pk_bf16(v1[2], v1[3]);
                    *(u32x4*)(rowp + bj * HALF) = w; } }
    }
};

template <bool I8> __device__ __forceinline__ f32x4 mma1(i32x4 b, i32x4 a, f32x4 c) { return __builtin_amdgcn_mfma_f32_16x16x32_bf16(__builtin_bit_cast(bf16x8, b), __builtin_bit_cast(bf16x8, a), c, 0, 0, 0); }
template <bool I8> __device__ __forceinline__ i32x4 mma1(i32x4 b, i32x4 a, i32x4 c) { return __builtin_amdgcn_mfma_i32_16x16x64_i8(b, a, c, 0, 0, 0); }
template <class Epi, class Sched, bool ALIGN_EPI>
__device__ __forceinline__ void gemm_phase(PG8_LAS unsigned char* lds, const Gemm g, const Sched& S, const Epi& E) {
    const int tid = threadIdx.x, wid = __builtin_amdgcn_readfirstlane(tid >> 6), lane = tid & 63, wr = wid >> 2, wc = wid & 3, fr = lane & 15, fq = lane >> 4;
    const int nt = g.KB / (BK * 2);
    typedef typename Epi::acc_t acc_t; typedef i32x4 frag_t;
    unsigned voffA[2], voffB[2];
#pragma unroll
    for (int i = 0; i < 2; ++i) { int R, C; stage_rc(tid * 16 + i * 8192, R, C); const int Rb = Epi::PERM ? ((R & ~31) + perm32(R & 31)) : R;
        voffA[i] = (unsigned)(R * g.ldaB + C * 2); voffB[i] = (unsigned)(Rb * g.ldbB + C * 2); }
    const size_t kstepA = (size_t)g.kstepA, kstepB = (size_t)g.kstepB;
    const size_t hstepA = (size_t)HALF * g.ldaB, hstepB = (size_t)HALF * g.ldbB;
    const size_t tstepA = g.tstepA, tstepB = g.tstepB;
    const size_t acstep = (size_t)g.a_cbytes;
    const unsigned ldsw = (unsigned)wid * 1024u;
    const int aoff = lds_byte(wr * 64 + fr, fq * 8), boff = lds_byte(wc * 32 + fr, fq * 8);
#define PG8_SA(b, h) (((b) * 2 + (h)) * HTB)
#define PG8_SB(b, h) ((4 + (b) * 2 + (h)) * HTB)
#define PG8_STAGE(bufoff, gbase, voff) do { _Pragma("unroll") for (int _i = 0; _i < 2; ++_i) \
        __builtin_amdgcn_global_load_lds((const unsigned*)((const char*)(gbase) + (voff)[_i]), (PG8_LAS unsigned*)(lds + (bufoff) + ldsw + _i * 8192), 16, 0, 0); } while (0)
#define PG8_LDA(dst, b, h) do { _Pragma("unroll") for (int m = 0; m < 4; ++m) _Pragma("unroll") for (int k = 0; k < 2; ++k) dst[m][k] = *(const PG8_LAS frag_t*)(lds + PG8_SA(b, h) + aoff + m * 2048 + k * 1024); } while (0)
#define PG8_LDB(dst, b, h) do { _Pragma("unroll") for (int n = 0; n < 2; ++n) _Pragma("unroll") for (int k = 0; k < 2; ++k) dst[n][k] = *(const PG8_LAS frag_t*)(lds + PG8_SB(b, h) + boff + n * 2048 + k * 1024); } while (0)
#define PG8_MMA(ai, bj, At, Bt) do { __builtin_amdgcn_s_setprio(1); _Pragma("unroll") for (int m = 0; m < 4; ++m) _Pragma("unroll") for (int n = 0; n < 2; ++n) _Pragma("unroll") for (int k = 0; k < 2; ++k) \
        acc[ai][bj][m][n] = mma1<Epi::I8>(Bt[n][k], At[m][k], acc[ai][bj][m][n]); __builtin_amdgcn_s_setprio(0); } while (0)
#define PG8_WAIT_V(n) asm volatile("s_waitcnt vmcnt(" #n ")" ::: "memory")
#define PG8_WAIT_L(n) asm volatile("s_waitcnt lgkmcnt(" #n ")" ::: "memory")
#define PG8_BAR __builtin_amdgcn_s_barrier()
#define PG8_SCHED __builtin_amdgcn_sched_barrier(0)
#define PG8_UA(u) ((const char*)g.A + (size_t)(u).pm * tstepA + (size_t)((u).pn >> 1) * acstep)
#define PG8_UB(u) ((const char*)g.Bt + (size_t)(u).pn * tstepB)
    Unit cur, nxt; int ui = 0;
    if (!S.next(0, cur)) return;
    acc_t acc[2][2][4][2];
#pragma unroll
    for (int a = 0; a < 2; ++a)
#pragma unroll
        for (int b = 0; b < 2; ++b)
#pragma unroll
            for (int m = 0; m < 4; ++m)
#pragma unroll
                for (int n = 0; n < 2; ++n) acc[a][b][m][n] = (acc_t){0, 0, 0, 0};
    frag_t At[4][2], B0[2][2], B1[2][2];
    const char* cA = PG8_UA(cur); const char* cB = PG8_UB(cur);
    S.a_ready(cur);
    PG8_STAGE(PG8_SB(0, 0), cB, voffB); PG8_STAGE(PG8_SB(0, 1), cB + hstepB, voffB); PG8_STAGE(PG8_SA(0, 0), cA, voffA); PG8_STAGE(PG8_SA(0, 1), cA + hstepA, voffA);
    if (wr == 1) PG8_BAR;
    PG8_WAIT_V(2); PG8_BAR;
    PG8_STAGE(PG8_SB(1, 0), cB + kstepB, voffB); PG8_STAGE(PG8_SA(1, 0), cA + kstepA, voffA); PG8_STAGE(PG8_SB(1, 1), cB + hstepB + kstepB, voffB);
    PG8_WAIT_V(6); PG8_BAR;
    for (;;) {
        const bool has_next = S.next(ui + 1, nxt);
        const char* nA = has_next ? PG8_UA(nxt) : cA; const char* nB = has_next ? PG8_UB(nxt) : cB;
        for (int t = 0; t < nt; t += 2) {
            const bool last = (t == nt - 2);
            const char* a1 = cA + (size_t)(t + 1) * kstepA;
            const char* a2 = last ? nA : cA + (size_t)(t + 2) * kstepA; const char* b2 = last ? nB : cB + (size_t)(t + 2) * kstepB;
            const char* a3 = a2 + kstepA; const char* b3 = b2 + kstepB;
            if (last && has_next) S.a_ready(nxt);
            PG8_LDB(B0, 0, 0); PG8_LDB(B1, 0, 1); PG8_SCHED; PG8_LDA(At, 0, 0); PG8_STAGE(PG8_SA(1, 1), a1 + hstepA, voffA);
            PG8_WAIT_V(8); PG8_WAIT_L(0); PG8_BAR; PG8_MMA(0, 0, At, B0); PG8_MMA(0, 1, At, B1); PG8_BAR; PG8_SCHED;
            PG8_LDA(At, 0, 1); PG8_STAGE(PG8_SB(0, 0), b2, voffB); PG8_STAGE(PG8_SB(0, 1), b2 + hstepB, voffB); PG8_STAGE(PG8_SA(0, 0), a2, voffA);
            PG8_WAIT_V(8); PG8_WAIT_L(0); PG8_BAR; PG8_MMA(1, 0, At, B0); PG8_MMA(1, 1, At, B1); PG8_BAR; PG8_SCHED;
            PG8_LDB(B0, 1, 0); PG8_LDB(B1, 1, 1); PG8_SCHED; PG8_LDA(At, 1, 0); PG8_STAGE(PG8_SA(0, 1), a2 + hstepA, voffA);
            PG8_WAIT_V(8); PG8_WAIT_L(0); PG8_BAR; PG8_MMA(0, 0, At, B0); PG8_MMA(0, 1, At, B1); PG8_BAR; PG8_SCHED;
            PG8_LDA(At, 1, 1); PG8_STAGE(PG8_SB(1, 0), b3, voffB); PG8_STAGE(PG8_SB(1, 1), b3 + hstepB, voffB); PG8_STAGE(PG8_SA(1, 0), a3, voffA);
            PG8_WAIT_V(8); PG8_WAIT_L(0); PG8_BAR; PG8_MMA(1, 0, At, B0); PG8_MMA(1, 1, At, B1); PG8_BAR; PG8_SCHED;
        }
        if constexpr (ALIGN_EPI) { if (wr == 0) PG8_BAR; }
        E(acc, cur, wr, wc, fr, fq); S.done(cur);
        if (!has_next) break;
#pragma unroll
        for (int a = 0; a < 2; ++a)
#pragma unroll
            for (int b = 0; b < 2; ++b)
#pragma unroll
                for (int m = 0; m < 4; ++m)
#pragma unroll
                    for (int n = 0; n < 2; ++n) acc[a][b][m][n] = (acc_t){0, 0, 0, 0};
        cur = nxt; cA = nA; cB = nB; ++ui;
        if constexpr (ALIGN_EPI) { if (wr == 1) PG8_BAR; }
    }
    PG8_WAIT_V(0);
    if constexpr (!ALIGN_EPI) { if (wr == 0) PG8_BAR; }
    PG8_BAR;
#undef PG8_SA
#undef PG8_SB
#undef PG8_STAGE
#undef PG8_LDA
#undef PG8_LDB
#undef PG8_MMA
#undef PG8_WAIT_V
#undef PG8_WAIT_L
#undef PG8_BAR
#undef PG8_SCHED
#undef PG8_UA
#undef PG8_UB
}
}

constexpr int NWAVES = 8;
#ifndef MK_N_LAUNCHES
#define MK_N_LAUNCHES 1
#endif
constexpr int N_PHASES = 13;
#ifndef WGM_GU
#define WGM_GU 4
#endif
#ifndef BG_IN_P2
#define BG_IN_P2 1
#endif
#ifndef WD2_IN_P10
#define WD2_IN_P10 1
#endif
#ifndef BG_TR
#define BG_TR 2
#endif
#ifndef NBG
#define NBG 0
#endif
#ifndef REV_DOWN
#define REV_DOWN 1
#endif
#ifndef WGM_DOWN
#define WGM_DOWN 4
#endif
#ifndef PROBE
#define PROBE 0
#endif
#ifndef PROBE_PH
#define PROBE_PH 0
#endif
constexpr int N_LAUNCHES = MK_N_LAUNCHES;
static_assert(N_LAUNCHES == 1 || N_LAUNCHES == N_PHASES, "MK_N_LAUNCHES is 1 or 13");

constexpr int M = 24576, M_PROMPT = 16384, SEQ_P = 8192, SEQ_S = 2048;
constexpr int D = 4096, FF = 11008, NGU = 2 * FF, DIN = 6144, DA = 2048, DB = 2048, NH = 16, HD = 128, CH = 128, DPG = 512;
constexpr float EPS = 1e-6f;

constexpr size_t MiB = 1u << 20;
constexpr size_t WS_CTL = 0, CTL_ZERO_BYTES = 64 * 1024;
constexpr size_t WS_STATS = 1 * MiB;
constexpr size_t WS_SA = 7 * MiB, WS_SW1 = 7 * MiB + 256 * 1024, WS_SW2 = 7 * MiB + 512 * 1024;
constexpr size_t WS_WGU1 = 8 * MiB, WS_WD1 = 94 * MiB, WS_WGU2 = 180 * MiB, WS_WD2 = 266 * MiB;
constexpr size_t WS_WIN = 352 * MiB, WS_WOUT = 400 * MiB, WS_WSP = 432 * MiB, WS_WPT = 433 * MiB;
constexpr size_t WS_A = 436 * MiB;
constexpr size_t WS_HID = 628 * MiB;
constexpr size_t WS_Z = WS_HID, WS_YCAT = WS_HID + 288 * MiB;
constexpr size_t WS_Y = 1144 * MiB;
constexpr size_t WS_END = 1336 * MiB;
static_assert((4096 + 3456) * 4 <= (int)CTL_ZERO_BYTES && WS_STATS + (size_t)M * 64 * 4 <= WS_SA && WS_SA + (size_t)M * 4 <= WS_SW1 && WS_SW1 + NGU * 4 <= WS_SW2 && WS_SW2 + NGU * 4 <= WS_WGU1, "ws map 0");
static_assert(WS_WGU1 + (size_t)NGU * D <= WS_WD1 && WS_WD1 + (size_t)D * FF * 2 <= WS_WGU2 && WS_WGU2 + (size_t)NGU * D <= WS_WD2 && WS_WD2 + (size_t)D * FF * 2 <= WS_WIN, "ws map 1");
static_assert(WS_WIN + (size_t)DIN * D * 2 <= WS_WOUT && WS_WOUT + (size_t)D * D * 2 <= WS_WSP && WS_WSP + (size_t)NH * CH * CH * 2 <= WS_WPT && WS_WPT + (size_t)DB * DPG * 2 <= WS_A, "ws map 2");
static_assert(WS_A + (size_t)M * D * 2 <= WS_HID && WS_HID + (size_t)M * FF * 2 <= WS_Y && WS_Y + (size_t)M * D * 2 <= WS_END && WS_YCAT + (size_t)M * D * 2 <= WS_Y && WS_Z + (size_t)M * DIN * 2 <= WS_YCAT, "ws map 3");
constexpr int CW_TMO = 0, CW_CODE = 1;
constexpr int CW_BAR = 4096, CW_BAR_END = CW_BAR + 3456;
constexpr int CW_PROBE = 512, CW_QUEUE = 640, CW_QUEUE2 = 704, CW_QUEUE3 = 768;

constexpr int RING_OFF = 0, RING_BYTES = 131072;
constexpr int LDSCTL_OFF = RING_BYTES, MISC_OFF = LDSCTL_OFF + 320;
constexpr int LDSX_OFF = LDSCTL_OFF + 1024;
constexpr int LDS_BYTES = 147456;
static_assert(MISC_OFF + 128 <= LDSX_OFF && LDSX_OFF + 4096 <= LDS_BYTES, "LDS map");

#define GAS __attribute__((address_space(1)))
#define LAS __attribute__((address_space(3)))
typedef unsigned short bf16;
typedef unsigned v4u __attribute__((ext_vector_type(4)));
typedef unsigned v2u __attribute__((ext_vector_type(2)));
typedef float f32x4 __attribute__((ext_vector_type(4)));
typedef short bf16x8 __attribute__((ext_vector_type(8)));
typedef GAS unsigned gu32;
#define RLX_AGENT __ATOMIC_RELAXED, __HIP_MEMORY_SCOPE_AGENT
#define LDS_WAIT() asm volatile("s_waitcnt lgkmcnt(0)" ::: "memory")
#define VM_WAIT() asm volatile("s_waitcnt vmcnt(0)" ::: "memory")
__device__ __forceinline__ unsigned f2bf(float f) { unsigned u = __builtin_bit_cast(unsigned, f); return (u + 0x7fffu + ((u >> 16) & 1u)) >> 16; }
__device__ __forceinline__ unsigned pk2(float lo, float hi) { return f2bf(lo) | (f2bf(hi) << 16); }
__device__ __forceinline__ float bf_lo(unsigned w) { return __builtin_bit_cast(float, w << 16); }
__device__ __forceinline__ float bf_hi(unsigned w) { return __builtin_bit_cast(float, w & 0xffff0000u); }
__device__ __forceinline__ unsigned q8(float v) { return (unsigned)(int)__builtin_rintf(v) & 255u; }
__device__ __forceinline__ unsigned pk4q(float a, float b, float c, float d) { return q8(a) | (q8(b) << 8) | (q8(c) << 16) | (q8(d) << 24); }

#define XB_TMO      128
#define XB_XCNT(j)  (256  + 64 * (j))
#define XB_XSUB(j)  (1280 + 64 * (j))
#define XB_XGEN(j)  (2304 + 64 * (j))
#define XB_TOP      3328
#define XB_TOPGEN   3392
#define XCD_BAR_WORDS 3456
#define XB_SPIN_CAP (1u << 18)

__device__ __forceinline__ unsigned xb_ld(unsigned* p)              { return __hip_atomic_load(p, __ATOMIC_RELAXED, __HIP_MEMORY_SCOPE_AGENT); }
__device__ __forceinline__ unsigned xb_add(unsigned* p, unsigned v) { return __hip_atomic_fetch_add(p, v, __ATOMIC_RELAXED, __HIP_MEMORY_SCOPE_AGENT); }
__device__ __forceinline__ unsigned xb_xcc_id() { return (unsigned)__builtin_amdgcn_s_getreg((3 << 11) | 20) & 0xFu; }
#define XB_SPIN(cond, bar) do { unsigned _sp = 0; while (cond) { __builtin_amdgcn_s_sleep(1); \
    if ((++_sp & 255u) == 0u) { if (xb_ld(&(bar)[XB_TMO])) break; if (_sp > XB_SPIN_CAP) { atomicAdd(&(bar)[XB_TMO], 1u); break; } } } } while (0)

struct XcdBarrier {
    unsigned* bar; unsigned x;
    volatile LAS unsigned* st;
};

__device__ __forceinline__ XcdBarrier xcd_barrier_post(unsigned* bar, volatile LAS unsigned* st) {
    XcdBarrier b; b.bar = bar; b.x = xb_xcc_id(); b.st = st;
    if (threadIdx.x == 0) (void)xb_add(&bar[XB_XCNT(b.x)], 1u);
    return b;
}
__device__ __forceinline__ void xcd_barrier_complete(unsigned* bar, unsigned x, unsigned& nloc, unsigned& nx) {
    const unsigned G = gridDim.x * gridDim.y * gridDim.z;
    unsigned sum, cnt, mine, sp = 0u;
    for (;;) {
        sum = 0u; cnt = 0u; mine = 0u;
#pragma unroll
        for (unsigned j = 0; j < 16; ++j) { const unsigned c = xb_ld(&bar[XB_XCNT(j)]); sum += c; cnt += (c > 0u) ? 1u : 0u; mine = (j == x) ? c : mine; }
        if (sum == G) break;
        __builtin_amdgcn_s_sleep(1);
        if ((++sp & 255u) == 0u) { if (xb_ld(&bar[XB_TMO])) break; if (sp > XB_SPIN_CAP) { atomicAdd(&bar[XB_TMO], 1u); break; } }
    }
    nloc = mine > 0u ? mine : 1u; nx = cnt > 0u ? cnt : 1u;
}

__device__ __forceinline__ void xcd_barrier(const XcdBarrier& b) {
    asm volatile("s_waitcnt vmcnt(0)" ::: "memory");
    __syncthreads();
    if (threadIdx.x == 0) {
        unsigned* bar = b.bar;
        __builtin_amdgcn_s_waitcnt(0);
        unsigned nloc = b.st[0], nx = b.st[1];
        if (nloc == 0u) { xcd_barrier_complete(bar, b.x, nloc, nx); b.st[0] = nloc; b.st[1] = nx; }
        const unsigned old = xb_add(&bar[XB_XSUB(b.x)], 1u);
        const unsigned gen = old / nloc;
        if (old + 1u == (gen + 1u) * nloc) {
            __builtin_amdgcn_fence(__ATOMIC_RELEASE, "agent");
            asm volatile("s_waitcnt vmcnt(0)" ::: "memory");
            const unsigned og = xb_add(&bar[XB_TOP], 1u);
            const unsigned tg = og / nx;
            if (og + 1u == (tg + 1u) * nx) xb_add(&bar[XB_TOPGEN], 1u);
            else XB_SPIN(xb_ld(&bar[XB_TOPGEN]) == tg, bar);
            __builtin_amdgcn_fence(__ATOMIC_ACQUIRE, "agent");
            xb_add(&bar[XB_XGEN(b.x)], 1u);
            asm volatile("s_waitcnt vmcnt(0)" ::: "memory");
        } else {
            XB_SPIN(xb_ld(&bar[XB_XGEN(b.x)]) == gen, bar);
            __builtin_amdgcn_fence(__ATOMIC_ACQUIRE, "agent");
            asm volatile("s_waitcnt vmcnt(0)" ::: "memory");
        }
    }
    __syncthreads();
}

struct Frame {
    LAS unsigned char* lds;
    volatile LAS unsigned* MISC;
    gu32* ctl;
    int tid, lane, wave;
    int vcu, G;
};

__device__ __forceinline__ float wave_sum(float v) {
#pragma unroll
    for (int o = 1; o < 64; o <<= 1) v += __shfl_xor(v, o);
    return v;
}
__device__ __forceinline__ float wave_max(float v) {
#pragma unroll
    for (int o = 1; o < 64; o <<= 1) v = fmaxf(v, __shfl_xor(v, o));
    return v;
}
template <bool TILED>
__device__ __forceinline__ void p0_transpose_item(const float* W, int K, int N, bf16* WT, int row_off, LAS float* scr, int item, int lane) {
    const int nblk = N / 32, kb = item / nblk, nb = item % nblk, k0 = 64 * kb, n0 = 32 * nb;
#pragma unroll 8
    for (int i = 0; i < 32; ++i) { const int kk = 2 * i + (lane >> 5); scr[kk * 33 + (lane & 31)] = W[(size_t)(k0 + kk) * N + n0 + (lane & 31)]; }
    LDS_WAIT(); asm volatile("" ::: "memory");
    const int c = lane & 7;
#pragma unroll
    for (int j = 0; j < 4; ++j) { const int n = (lane >> 3) + 8 * j; const LAS float* s = scr + (8 * c) * 33 + n;
        v4u o; o.x = pk2(s[0 * 33], s[1 * 33]); o.y = pk2(s[2 * 33], s[3 * 33]); o.z = pk2(s[4 * 33], s[5 * 33]); o.w = pk2(s[6 * 33], s[7 * 33]);
        if constexpr (TILED) { const int r = row_off + n0 + n;
            *(GAS v4u*)((GAS char*)WT + ((size_t)(r >> 8) * (K / 64) + kb) * 32768 + (r & 255) * 128 + 16 * c) = o; }
        else *(GAS v4u*)(WT + (size_t)(row_off + n0 + n) * K + k0 + 8 * c) = o; }
    LDS_WAIT(); asm volatile("" ::: "memory");
}
struct TJob { const float* W; bf16* WT; int K, N, row_off, tiled; const float* ks; };
__device__ __forceinline__ void tr_load(const TJob& J, int item, int lane, f32x4 (&v)[8]) {
    const int nblk = J.N / 32, kb = item / nblk, nb = item % nblk;
    const GAS f32x4* p = (const GAS f32x4*)(J.W + (size_t)(64 * kb + (lane >> 3)) * J.N + 32 * nb) + (lane & 7);
#pragma unroll
    for (int i = 0; i < 8; ++i) v[i] = __builtin_nontemporal_load(&p[(size_t)i * 8 * (J.N / 4)]);
    if (J.ks) {
        float s[8];
#pragma unroll
        for (int i = 0; i < 8; ++i) s[i] = J.ks[64 * kb + (lane >> 3) + 8 * i];
#pragma unroll
        for (int i = 0; i < 8; ++i) v[i] = v[i] * s[i];
    }
}
__device__ __forceinline__ void tr_commit(const TJob& J, int item, int lane, const f32x4 (&v)[8], LAS float* scr) {
    const int nblk = J.N / 32, kb = item / nblk, nb = item % nblk, k0 = 64 * kb, n0 = 32 * nb;
#pragma unroll
    for (int i = 0; i < 8; ++i) { LAS float* d = scr + (8 * i + (lane >> 3)) * 33 + 4 * (lane & 7); d[0] = v[i].x; d[1] = v[i].y; d[2] = v[i].z; d[3] = v[i].w; }
    LDS_WAIT(); asm volatile("" ::: "memory");
    const int c = lane & 7;
#pragma unroll
    for (int j = 0; j < 4; ++j) { const int n = (lane >> 3) + 8 * j; const LAS float* s = scr + (8 * c) * 33 + n;
        v4u o; o.x = pk2(s[0 * 33], s[1 * 33]); o.y = pk2(s[2 * 33], s[3 * 33]); o.z = pk2(s[4 * 33], s[5 * 33]); o.w = pk2(s[6 * 33], s[7 * 33]);
        const int r = J.row_off + n0 + n;
        if (J.tiled) __builtin_nontemporal_store(o, (GAS v4u*)((GAS char*)J.WT + ((size_t)(r >> 8) * (J.K / 64) + kb) * 32768 + (r & 255) * 128 + 16 * c));
        else __builtin_nontemporal_store(o, (GAS v4u*)(J.WT + (size_t)r * J.K + k0 + 8 * c)); }
    LDS_WAIT(); asm volatile("" ::: "memory");
}
__device__ __forceinline__ void p0_quant_item2(const float* W, float cm, signed char* WQ, int drow0, LAS float* scr, int kb, int n0, int lane) {
    const int k0 = 64 * kb;
#pragma unroll 8
    for (int i = 0; i < 32; ++i) { const int kk = 2 * i + (lane >> 5); scr[kk * 33 + (lane & 31)] = W[(size_t)(k0 + kk) * FF + n0 + (lane & 31)]; }
    LDS_WAIT(); asm volatile("" ::: "memory");
    const int c = lane & 3;
#pragma unroll
    for (int j = 0; j < 2; ++j) { const int n = (lane >> 2) + 16 * j; const LAS float* s = scr + (16 * c) * 33 + n;
        const float mxv = __shfl(cm, n); const float inv = mxv > 0.f ? 127.0f / mxv : 0.f;
        v4u o; o.x = pk4q(s[0 * 33] * inv, s[1 * 33] * inv, s[2 * 33] * inv, s[3 * 33] * inv); o.y = pk4q(s[4 * 33] * inv, s[5 * 33] * inv, s[6 * 33] * inv, s[7 * 33] * inv);
        o.z = pk4q(s[8 * 33] * inv, s[9 * 33] * inv, s[10 * 33] * inv, s[11 * 33] * inv); o.w = pk4q(s[12 * 33] * inv, s[13 * 33] * inv, s[14 * 33] * inv, s[15 * 33] * inv);
        *(GAS v4u*)(WQ + (size_t)(drow0 + n) * D + k0 + 16 * c) = o; }
    LDS_WAIT(); asm volatile("" ::: "memory");
}
__device__ __forceinline__ const float* x_row(const float* xp, const float* xs, int m) { return m < M_PROMPT ? xp + (size_t)m * D : xs + (size_t)(m - M_PROMPT) * D; }

__device__ __forceinline__ void quant_row_store(int lane, const f32x4 (&a)[16], signed char* qrow, float* sa) {
    float mx = 0.f;
#pragma unroll
    for (int j = 0; j < 16; ++j) mx = fmaxf(fmaxf(mx, fmaxf(fabsf(a[j].x), fabsf(a[j].y))), fmaxf(fabsf(a[j].z), fabsf(a[j].w)));
    mx = wave_max(mx);
    const float inv = mx > 0.f ? 127.0f / mx : 0.f;
    GAS unsigned* o = (GAS unsigned*)qrow + lane;
#pragma unroll
    for (int j = 0; j < 16; ++j) o[64 * j] = pk4q(a[j].x * inv, a[j].y * inv, a[j].z * inv, a[j].w * inv);
    if (lane == 0) *sa = mx > 0.f ? mx * (1.0f / 127.0f) : 1.0f;
}
__device__ __forceinline__ void rms_row_to_q(int lane, const float* xrow, const float* g, signed char* qrow, float* sa) {
    const GAS f32x4* xr = (const GAS f32x4*)xrow + lane; const GAS f32x4* gr = (const GAS f32x4*)g + lane;
    f32x4 v[16]; float s = 0.f;
#pragma unroll
    for (int j = 0; j < 16; ++j) v[j] = __builtin_nontemporal_load(&xr[64 * j]);
    __builtin_amdgcn_sched_barrier(0);
#pragma unroll
    for (int j = 0; j < 16; ++j) s += (v[j].x * v[j].x + v[j].y * v[j].y) + (v[j].z * v[j].z + v[j].w * v[j].w);
    const float r = 1.0f / sqrtf(wave_sum(s) * (1.f / D) + EPS);
#pragma unroll
    for (int j = 0; j < 16; ++j) v[j] = v[j] * r * gr[64 * j];
    quant_row_store(lane, v, qrow, sa);
}

template <int MODE, bool BASE_X, int DIR>
__device__ __forceinline__ void norm_phase(Frame& F, const float* baseP, const float* baseS, const bf16* Y, const float* stats, float c, const float* gpost, const float* g2, float* OUT, bf16* A, signed char* AQ, float* SA) {
    LAS f32x4* gl = (LAS f32x4*)(F.lds + RING_OFF);
    for (int i = F.tid; i < D / 4; i += NWAVES * 64) { gl[i] = ((const GAS f32x4*)gpost)[i]; gl[1024 + i] = ((const GAS f32x4*)g2)[i]; }
    LDS_WAIT(); __syncthreads();
    const int lane = F.lane, nx = (F.G % 8 == 0) ? 8 : 1, gpx = F.G / nx, MX = M / nx, wpx = gpx * NWAVES, xq = F.vcu / gpx, j0 = (F.vcu % gpx) * NWAVES + F.wave;
    for (int j = j0; j < MX; j += wpx) {
        const int m = xq * MX + (DIR ? MX - 1 - j : j);
        const GAS f32x4* br = (const GAS f32x4*)x_row(baseP, baseS, m) + lane;
        GAS v2u* hb = (GAS v2u*)((bf16*)(OUT + (size_t)m * D) + D) + lane;
        const GAS v2u* yr = (const GAS v2u*)(Y + (size_t)m * D) + lane;
        const float ssy = wave_sum(stats[(size_t)m * 64 + lane]);
        const float ry = c / sqrtf(ssy * (1.f / D) + EPS);
        constexpr int NB = (PROBE != 0) ? 8 : 16;
        f32x4 h[16]; v2u yv[NB], bv[BASE_X ? 1 : NB]; float s = 0.f;
#pragma unroll
        for (int jb = 0; jb < 16; jb += NB) {
#pragma unroll
            for (int j = 0; j < NB; ++j) { if constexpr (BASE_X) h[jb + j] = br[64 * (jb + j)]; else bv[j] = hb[64 * (jb + j)];
                yv[j] = yr[64 * (jb + j)]; }
            __builtin_amdgcn_sched_barrier(0);
#pragma unroll
            for (int j = 0; j < NB; ++j) { f32x4 b; if constexpr (BASE_X) b = h[jb + j]; else { const v2u bb = bv[j]; b.x = bf_lo(bb.x); b.y = bf_hi(bb.x); b.z = bf_lo(bb.y); b.w = bf_hi(bb.y); }
                const v2u yy = yv[j]; const f32x4 gp = gl[64 * (jb + j) + lane];
                f32x4 y; y.x = bf_lo(yy.x); y.y = bf_hi(yy.x); y.z = bf_lo(yy.y); y.w = bf_hi(yy.y);
                h[jb + j] = b + y * ry * gp; s += (h[jb + j].x * h[jb + j].x + h[jb + j].y * h[jb + j].y) + (h[jb + j].z * h[jb + j].z + h[jb + j].w * h[jb + j].w); }
            if (NB < 16) __builtin_amdgcn_sched_barrier(0);
        }
        const float rh = 1.0f / sqrtf(wave_sum(s) * (1.f / D) + EPS);
        if constexpr (MODE == 1) {
            GAS f32x4* ho = (GAS f32x4*)(OUT + (size_t)m * D) + lane;
#pragma unroll
            for (int j = 0; j < 16; ++j) { const f32x4 gg = gl[1024 + 64 * j + lane]; ho[64 * j] = h[j] * rh * gg; }
        } else if constexpr (MODE == 0) {
#pragma unroll
            for (int j = 0; j < 16; ++j) { v2u hw; hw.x = pk2(h[j].x, h[j].y); hw.y = pk2(h[j].z, h[j].w); hb[64 * j] = hw; }
            if (lane == 0) SA[m] = rh;
        } else {
#pragma unroll
            for (int j = 0; j < 16; ++j) { const f32x4 gg = gl[1024 + 64 * j + lane]; v2u hw; hw.x = pk2(h[j].x, h[j].y); hw.y = pk2(h[j].z, h[j].w); hb[64 * j] = hw; h[j] = h[j] * rh * gg; }
            quant_row_store(lane, h, AQ + (size_t)m * D, SA + m);
        }
    }
}

__device__ __forceinline__ void spatial_units(Frame& F, int u0, int u1, const bf16* Z, const bf16* WSP, const float* b_sp, const float* v_norm, bf16* YCAT) {
    constexpr int VS = 136, VBUF = 128 * VS * 2;
    const int tid = F.tid, s = tid >> 2, q = tid & 3, w = F.wave, fr = F.lane & 15, fq = F.lane >> 4, t = 16 * w + fr;
    if (u0 >= u1) return;
    v4u vw[4];
    { const GAS v4u* src = (const GAS v4u*)(Z + (size_t)((u0 / NH) * CH + s) * DIN + DA + (u0 % NH) * HD + q * 32);
#pragma unroll
      for (int i = 0; i < 4; ++i) vw[i] = src[i]; }
    for (int ui = u0; ui < u1; ++ui) {
        const int cidx = ui / NH, h = ui % NH, r0 = cidx * CH;
        LAS bf16* vT = (LAS bf16*)(F.lds + RING_OFF + ((ui - u0) & 1) * VBUF);
        bf16x8 af[4];
#pragma unroll
        for (int kk = 0; kk < 4; ++kk) af[kk] = *(const GAS bf16x8*)(WSP + (size_t)h * CH * CH + t * CH + kk * 32 + fq * 8);
        const GAS v4u* ur = (const GAS v4u*)(Z + (size_t)(r0 + t) * DIN + h * HD + 8 * fq);
        v4u uu[4];
#pragma unroll
        for (int p = 0; p < 4; ++p) uu[p] = ur[4 * p];
        const float bias = b_sp[h * CH + t];
        {   float v[32]; float ss = 0.f;
#pragma unroll
            for (int i = 0; i < 4; ++i) { v[8 * i + 0] = bf_lo(vw[i].x); v[8 * i + 1] = bf_hi(vw[i].x); v[8 * i + 2] = bf_lo(vw[i].y); v[8 * i + 3] = bf_hi(vw[i].y);
                v[8 * i + 4] = bf_lo(vw[i].z); v[8 * i + 5] = bf_hi(vw[i].z); v[8 * i + 6] = bf_lo(vw[i].w); v[8 * i + 7] = bf_hi(vw[i].w); }
#pragma unroll
            for (int j = 0; j < 32; ++j) ss += v[j] * v[j];
            ss += __shfl_xor(ss, 1); ss += __shfl_xor(ss, 2);
            const float r = 1.0f / sqrtf(ss * (1.f / HD) + EPS);
            const GAS f32x4* vn = (const GAS f32x4*)(v_norm + h * HD + q * 32);
#pragma unroll
            for (int j4 = 0; j4 < 8; ++j4) { const f32x4 gn = vn[j4];
                vT[(q * 32 + 4 * j4 + 0) * VS + s] = (bf16)f2bf(v[4 * j4 + 0] * r * gn.x); vT[(q * 32 + 4 * j4 + 1) * VS + s] = (bf16)f2bf(v[4 * j4 + 1] * r * gn.y);
                vT[(q * 32 + 4 * j4 + 2) * VS + s] = (bf16)f2bf(v[4 * j4 + 2] * r * gn.z); vT[(q * 32 + 4 * j4 + 3) * VS + s] = (bf16)f2bf(v[4 * j4 + 3] * r * gn.w); }
        }
        LDS_WAIT(); __syncthreads();
        if (ui + 1 < u1) { const int un = ui + 1; const GAS v4u* src = (const GAS v4u*)(Z + (size_t)((un / NH) * CH + s) * DIN + DA + (un % NH) * HD + q * 32);
#pragma unroll
            for (int i = 0; i < 4; ++i) vw[i] = src[i]; }
        f32x4 acc[8];
#pragma unroll
        for (int n = 0; n < 8; ++n) { acc[n] = (f32x4){0.f, 0.f, 0.f, 0.f};
#pragma unroll
            for (int kk = 0; kk < 4; ++kk) { const bf16x8 bfr = *(const LAS bf16x8*)(vT + (32 * (n >> 1) + 8 * (fr >> 2) + 4 * (n & 1) + (fr & 3)) * VS + kk * 32 + fq * 8);
                acc[n] = __builtin_amdgcn_mfma_f32_16x16x32_bf16(bfr, af[kk], acc[n], 0, 0, 0); } }
        GAS v4u* orow = (GAS v4u*)(YCAT + (size_t)(r0 + t) * D + h * HD + 8 * fq);
#pragma unroll
        for (int p = 0; p < 4; ++p) { const v4u w = uu[p]; const f32x4 a0 = acc[2 * p], a1 = acc[2 * p + 1];
            v4u o; o.x = pk2(bf_lo(w.x) * (a0[0] + bias), bf_hi(w.x) * (a0[1] + bias)); o.y = pk2(bf_lo(w.y) * (a0[2] + bias), bf_hi(w.y) * (a0[3] + bias));
            o.z = pk2(bf_lo(w.z) * (a1[0] + bias), bf_hi(w.z) * (a1[1] + bias)); o.w = pk2(bf_lo(w.w) * (a1[2] + bias), bf_hi(w.w) * (a1[3] + bias));
            orow[4 * p] = o; }
    }
    LDS_WAIT(); __syncthreads();
}

__device__ __forceinline__ void acc8(float (&S)[8], const v4u w, float sgn) {
    S[0] += sgn * bf_lo(w.x); S[1] += sgn * bf_hi(w.x); S[2] += sgn * bf_lo(w.y); S[3] += sgn * bf_hi(w.y); S[4] += sgn * bf_lo(w.z); S[5] += sgn * bf_hi(w.z); S[6] += sgn * bf_lo(w.w); S[7] += sgn * bf_hi(w.w); }
template <int HW>
__device__ __forceinline__ void pool_strip8(const bf16* Z, bf16* PB, int strip, int cg) {
    const int m0 = strip * 8;
    const int s0 = (m0 < M_PROMPT) ? (m0 & ~(SEQ_P - 1)) : (M_PROMPT + ((m0 - M_PROMPT) & ~(SEQ_S - 1)));
    const int len = (m0 < M_PROMPT) ? SEQ_P : SEQ_S, t0 = m0 - s0;
    const bf16* zc = Z + (size_t)s0 * DIN + 2 * DA + 8 * cg;
    constexpr int NR = 2 * HW + 7;
    v4u r[NR];
#pragma unroll
    for (int j = 0; j < NR; ++j) { const int t = t0 - HW + j; r[j] = (v4u){0u, 0u, 0u, 0u}; if (t >= 0 && t < len) r[j] = *(const GAS v4u*)(zc + (size_t)t * DIN); }
    float S[8];
#pragma unroll
    for (int i = 0; i < 8; ++i) S[i] = 0.f;
#pragma unroll
    for (int j = 0; j < 2 * HW; ++j) acc8(S, r[j], 1.0f);
#pragma unroll
    for (int i = 0; i < 8; ++i) { const int t = t0 + i;
        const int lo = (t - HW) > 0 ? (t - HW) : 0, hi = (t + HW) < len ? (t + HW) : len;
        const float inv = 1.0f / (float)(hi - lo); const v4u w = r[i + HW];
        v4u o; o.x = pk2(S[0] * inv - bf_lo(w.x), S[1] * inv - bf_hi(w.x)); o.y = pk2(S[2] * inv - bf_lo(w.y), S[3] * inv - bf_hi(w.y));
        o.z = pk2(S[4] * inv - bf_lo(w.z), S[5] * inv - bf_hi(w.z)); o.w = pk2(S[6] * inv - bf_lo(w.w), S[7] * inv - bf_hi(w.w));
        *(GAS v4u*)(PB + (size_t)(s0 + t) * DB + 8 * cg) = o;
        if (i < 7) { acc8(S, r[i + 2 * HW], 1.0f); acc8(S, r[i], -1.0f); } }
}

struct Args { const float* in[22]; float* out; unsigned char* ws; int ph_lo, ph_hi; };
__global__ void __launch_bounds__(NWAVES * 64, 2) mk_fwd(Args args) {
    extern __shared__ __attribute__((aligned(16))) unsigned char lds[];
    Frame F;
    F.lds = (LAS unsigned char*)lds;
    F.MISC = (volatile LAS unsigned*)(F.lds + MISC_OFF);
    F.tid = threadIdx.x; F.lane = F.tid & 63; F.wave = __builtin_amdgcn_readfirstlane(F.tid >> 6);
    F.G = gridDim.x; { const int bx = blockIdx.x; F.vcu = (F.G % 8 == 0) ? (bx % 8) * (F.G / 8) + bx / 8 : bx; }
    unsigned char* ws = args.ws;
    F.ctl = (gu32*)(ws + WS_CTL);
    for (int u = F.tid; u < (LDS_BYTES - LDSCTL_OFF) / 4; u += NWAVES * 64) ((LAS unsigned*)(F.lds + LDSCTL_OFF))[u] = 0u;
    __syncthreads();
    XcdBarrier bar; bar.bar = (unsigned*)(F.ctl + CW_BAR); bar.x = 0; bar.st = nullptr;
    if (N_LAUNCHES == 1) bar = xcd_barrier_post((unsigned*)(F.ctl + CW_BAR), F.MISC + 8);
    volatile LAS unsigned long long* pr = (volatile LAS unsigned long long*)(F.lds + LDSX_OFF + 3072);
    if (PROBE != 0 && F.tid == 0) { pr[0] = 0ull; pr[1] = 0ull; pr[2] = __builtin_amdgcn_s_memrealtime(); }
#define PR_SET() do { if (F.tid == 0) pr[0] = __builtin_amdgcn_s_memrealtime(); } while (0)
#define PR_DIFF() do { if (F.tid == 0) pr[0] = __builtin_amdgcn_s_memrealtime() - pr[0]; } while (0)
    int pr_seam = 0;
#define GRID_BAR() do { if (N_LAUNCHES == 1) { const bool _m = (PROBE == 6) || (PROBE == 12 && pr_seam == PROBE_PH); if (_m && F.tid == 0) pr[3] = __builtin_amdgcn_s_memrealtime(); xcd_barrier(bar); if (_m && F.tid == 0) pr[1] += __builtin_amdgcn_s_memrealtime() - pr[3]; ++pr_seam; } } while (0)

    const float* x_p = args.in[0]; const float* x_s = args.in[1];
    signed char* WGU1 = (signed char*)(ws + WS_WGU1); bf16* WD1 = (bf16*)(ws + WS_WD1); signed char* WGU2 = (signed char*)(ws + WS_WGU2); bf16* WD2 = (bf16*)(ws + WS_WD2);
    bf16* WIN = (bf16*)(ws + WS_WIN); bf16* WOUT = (bf16*)(ws + WS_WOUT); bf16* WSP = (bf16*)(ws + WS_WSP); bf16* WPT = (bf16*)(ws + WS_WPT);
    bf16* AB = (bf16*)(ws + WS_A); signed char* AQ = (signed char*)(ws + WS_A); bf16* PB = (bf16*)(ws + WS_A);
    bf16* HID = (bf16*)(ws + WS_HID); bf16* ZB = (bf16*)(ws + WS_Z); bf16* YCAT = (bf16*)(ws + WS_YCAT); bf16* YB = (bf16*)(ws + WS_Y);
    float* STATS = (float*)(ws + WS_STATS); float* SA = (float*)(ws + WS_SA); float* SW1 = (float*)(ws + WS_SW1); float* SW2 = (float*)(ws + WS_SW2);
    float* H = args.out;

    const int lo = args.ph_lo, hi = args.ph_hi;
#define IN(k) (lo <= (k) && (k) < hi)
#define BOTH(k) (IN(k) && IN((k) == 0 ? 2 : (k) + 1))

    LAS float* const scr = (LAS float*)(F.lds + RING_OFF + F.wave * 16384);
    LAS float* const cmx = (LAS float*)(F.lds + LDSX_OFF);
    volatile LAS unsigned* const tkt = (volatile LAS unsigned*)(F.lds + LDSX_OFF + 2048);
    const int lane = F.lane;
    constexpr int NCBLK = FF / 32;
    auto gu_job = [&](const int mat, const int n0, const int jpar) __attribute__((always_inline)) {
            const float* W = args.in[mat == 0 ? 4 : mat == 1 ? 5 : mat == 2 ? 18 : 19];
            const int c4 = lane & 7, krow0 = F.wave * 512 + (lane >> 3) * 64;
            const GAS f32x4* p = (const GAS f32x4*)(W + (size_t)krow0 * FF + n0) + c4;
            v2u d[64]; float m0 = 0.f, m1 = 0.f, m2 = 0.f, m3 = 0.f;
#pragma unroll
            for (int ib = 0; ib < 4; ++ib) {
                f32x4 v[16];
#pragma unroll
                for (int i = 0; i < 16; ++i) v[i] = __builtin_nontemporal_load(&p[(size_t)(16 * ib + i) * (FF / 4)]);
                __builtin_amdgcn_sched_barrier(0);
#pragma unroll
                for (int i = 0; i < 16; ++i) { m0 = fmaxf(m0, fabsf(v[i].x)); m1 = fmaxf(m1, fabsf(v[i].y)); m2 = fmaxf(m2, fabsf(v[i].z)); m3 = fmaxf(m3, fabsf(v[i].w));
                    d[16 * ib + i].x = pg8::cvt_pk_bf16(v[i].x, v[i].y); d[16 * ib + i].y = pg8::cvt_pk_bf16(v[i].z, v[i].w); }
                __builtin_amdgcn_sched_barrier(0);
            }
#pragma unroll
            for (int o = 8; o < 64; o <<= 1) { m0 = fmaxf(m0, __shfl_xor(m0, o)); m1 = fmaxf(m1, __shfl_xor(m1, o)); m2 = fmaxf(m2, __shfl_xor(m2, o)); m3 = fmaxf(m3, __shfl_xor(m3, o)); }
            if (lane < 8) { LAS float* cw = cmx + (jpar * 8 + F.wave) * 32 + 4 * lane; cw[0] = m0; cw[1] = m1; cw[2] = m2; cw[3] = m3; }
            LDS_WAIT(); __syncthreads();
            f32x4 cm4 = (f32x4){0.f, 0.f, 0.f, 0.f};
#pragma unroll
            for (int w8 = 0; w8 < 8; ++w8) { const f32x4 cv = *(const LAS f32x4*)(cmx + (jpar * 8 + w8) * 32 + 4 * c4); cm4.x = fmaxf(cm4.x, cv.x); cm4.y = fmaxf(cm4.y, cv.y); cm4.z = fmaxf(cm4.z, cv.z); cm4.w = fmaxf(cm4.w, cv.w); }
            const float i0 = cm4.x > 0.f ? 127.0f / cm4.x : 0.f, i1 = cm4.y > 0.f ? 127.0f / cm4.y : 0.f, i2 = cm4.z > 0.f ? 127.0f / cm4.z : 0.f, i3 = cm4.w > 0.f ? 127.0f / cm4.w : 0.f;
            const int drow0 = 256 * (n0 >> 7) + (n0 & 127) + ((mat & 1) ? 128 : 0);
            signed char* WQ = mat < 2 ? WGU1 : WGU2;
            GAS char* q0p = (GAS char*)WQ + (size_t)(drow0 + 4 * c4) * D + krow0;
#pragma unroll
            for (int b = 0; b < 4; ++b) {
                v4u o0, o1, o2, o3;
#pragma unroll
                for (int a = 0; a < 4; ++a) { const v2u r0 = d[16 * b + 4 * a + 0], r1 = d[16 * b + 4 * a + 1], r2 = d[16 * b + 4 * a + 2], r3 = d[16 * b + 4 * a + 3];
                    o0[a] = pk4q(bf_lo(r0.x) * i0, bf_lo(r1.x) * i0, bf_lo(r2.x) * i0, bf_lo(r3.x) * i0); o1[a] = pk4q(bf_hi(r0.x) * i1, bf_hi(r1.x) * i1, bf_hi(r2.x) * i1, bf_hi(r3.x) * i1);
                    o2[a] = pk4q(bf_lo(r0.y) * i2, bf_lo(r1.y) * i2, bf_lo(r2.y) * i2, bf_lo(r3.y) * i2); o3[a] = pk4q(bf_hi(r0.y) * i3, bf_hi(r1.y) * i3, bf_hi(r2.y) * i3, bf_hi(r3.y) * i3); }
                *(GAS v4u*)(q0p + 0 * D + 16 * b) = o0; *(GAS v4u*)(q0p + 1 * D + 16 * b) = o1; *(GAS v4u*)(q0p + 2 * D + 16 * b) = o2; *(GAS v4u*)(q0p + 3 * D + 16 * b) = o3; }
            if (F.wave == 0 && lane < 8) { float* swp = (mat < 2 ? SW1 : SW2) + drow0 + 4 * c4;
                swp[0] = cm4.x > 0.f ? cm4.x * (1.0f / 127.0f) : 1.0f; swp[1] = cm4.y > 0.f ? cm4.y * (1.0f / 127.0f) : 1.0f; swp[2] = cm4.z > 0.f ? cm4.z * (1.0f / 127.0f) : 1.0f; swp[3] = cm4.w > 0.f ? cm4.w * (1.0f / 127.0f) : 1.0f; }
    };
    constexpr int I_D = (FF / 64) * (D / 32), I_IN = (D / 64) * (DIN / 32), I_OUT = (D / 64) * (D / 32), I_P = (DPG / 64) * (DPG / 32);
    constexpr int NITEMS = 2 * I_D + I_IN + I_OUT + 4 * I_P, NCT = NITEMS / 32, NCX = M / 32;
    constexpr int NC_D2 = I_D / 32;
    static_assert(I_D % 32 == 0, "WD2 chunks");
    constexpr int NCT1 = NCT - (WD2_IN_P10 ? NC_D2 : 0);
    constexpr int NTAIL = BG_TR == 1 ? NCT1 : BG_TR == 2 ? NC_D2 : 0;
    static_assert(NITEMS % 32 == 0 && M % 32 == 0 && I_D % 4 == 0 && I_IN % 4 == 0 && I_OUT % 4 == 0 && I_P % 4 == 0, "queue chunks");
    auto tr_chunk = [&](const int cur) __attribute__((always_inline)) {
        int r = (cur * 8 + F.wave) * 4;
        TJob J;
        if (r < I_D) J = TJob{args.in[6], WD1, FF, D, 0, 1, nullptr};
        else if ((r -= I_D) < I_IN) J = TJob{args.in[9], WIN, D, DIN, 0, 0, args.in[7]};
        else if ((r -= I_IN) < I_OUT) J = TJob{args.in[15], WOUT, D, D, 0, 0, nullptr};
        else if ((r -= I_OUT) < 4 * I_P) { const int gp = r / I_P; J = TJob{args.in[13] + (size_t)gp * DPG * DPG, WPT, DPG, DPG, gp * DPG, 0, nullptr}; r -= gp * I_P; }
        else { r -= 4 * I_P; J = TJob{args.in[20], WD2, FF, D, 0, 1, nullptr}; }
#pragma unroll
        for (int i = 0; i < 4; i += 2) { f32x4 va[8], vb[8];
            tr_load(J, r + i, lane, va); tr_load(J, r + i + 1, lane, vb);
            __builtin_amdgcn_sched_barrier(0);
            tr_commit(J, r + i, lane, va, scr); tr_commit(J, r + i + 1, lane, vb, scr); }
    };
    if (IN(0)) { if (PROBE == 11 && PROBE_PH == 0) PR_SET();
        constexpr int NJOBS = (BG_IN_P2 ? 2 : 4) * NCBLK;
        int jpar = 0;
        for (int job = F.vcu; job < NJOBS; job += F.G, jpar ^= 1) gu_job(job / NCBLK, (job % NCBLK) * 32, jpar);
        for (int i = (blockIdx.x * NWAVES * 64 + F.tid); i < NH * CH * CH / 4; i += F.G * NWAVES * 64) {
            const f32x4 v = ((const GAS f32x4*)args.in[10])[i]; v2u w; w.x = pk2(v.x, v.y); w.y = pk2(v.z, v.w); ((GAS v2u*)WSP)[i] = w; }
        constexpr int TB0 = BG_IN_P2 ? NTAIL : 0, NT0 = NCT1 - TB0, NCHUNK = NT0 + NCX;
        unsigned* qhead = (unsigned*)(F.ctl + CW_QUEUE);
        unsigned nxt = 0u; int tpar = 0;
        if (F.tid == 0) nxt = __hip_atomic_fetch_add(qhead, 1u, RLX_AGENT);
        for (;;) {
            if (F.tid == 0) tkt[tpar] = nxt;
            LDS_WAIT(); __syncthreads();
            const unsigned cur = tkt[tpar]; tpar ^= 1;
            if (cur >= (unsigned)NCHUNK) break;
            if (F.tid == 0) nxt = __hip_atomic_fetch_add(qhead, 1u, RLX_AGENT);
            if (cur < (unsigned)NT0) tr_chunk(TB0 + (int)cur);
            else { for (int i = 0; i < 4; ++i) { const int m = (((int)cur - NT0) * 8 + F.wave) * 4 + i; rms_row_to_q(lane, x_row(x_p, x_s, m), args.in[2], AQ + (size_t)m * D, SA + m); } }
        }
        if (BOTH(0)) GRID_BAR();
        if (PROBE == 11 && PROBE_PH == 0) PR_DIFF();
        if (PROBE == 9) do { if (F.tid == 0) pr[0] = __builtin_amdgcn_s_memrealtime() - pr[2]; } while (0);
    }
    if (IN(2)) { if (PROBE == 11 && PROBE_PH == 2) PR_SET();
        const int GG = BG_IN_P2 ? F.G - NBG : F.G;
        if ((int)blockIdx.x < GG) {
            pg8::Gemm g = pg8::gemm_rm(AQ, WGU1, D, D, D); pg8::StaticOrder S; S.init(M, NGU, GG, (int)blockIdx.x, WGM_GU);
            pg8::EpiSwiGLUQ E{HID, FF, SA, SW1};
            pg8::gemm_phase<pg8::EpiSwiGLUQ, pg8::StaticOrder, true>(F.lds + RING_OFF, g, S, E);
        }
        if (BG_IN_P2) {
            constexpr int NJ2 = 2 * NCBLK, NTK = NJ2 + NTAIL;
            unsigned* qhead = (unsigned*)(F.ctl + CW_QUEUE2);
            unsigned nxt = 0u; int tpar = 0, jpar = 0;
            if (F.tid == 0) nxt = __hip_atomic_fetch_add(qhead, 1u, RLX_AGENT);
            for (;;) {
                if (F.tid == 0) tkt[tpar] = nxt;
                LDS_WAIT(); __syncthreads();
                const unsigned cur = tkt[tpar]; tpar ^= 1;
                if (cur >= (unsigned)NTK) break;
                if (F.tid == 0) nxt = __hip_atomic_fetch_add(qhead, 1u, RLX_AGENT);
                if (cur < (unsigned)NJ2) { gu_job(2 + (int)cur / NCBLK, ((int)cur % NCBLK) * 32, jpar); jpar ^= 1; }
                else tr_chunk((int)cur - NJ2);
            }
        }
        if (BOTH(2)) GRID_BAR();
        if (PROBE == 11 && PROBE_PH == 2) PR_DIFF();
    }
    if (IN(3)) { if (PROBE == 11 && PROBE_PH == 3) PR_SET();
        pg8::Gemm g = pg8::gemm_tiled(HID, WD1, FF * 2); pg8::StaticOrder S; S.init(M, D, F.G, (int)blockIdx.x, WGM_DOWN, REV_DOWN);
        pg8::EpiYStats E{YB, D, STATS};
        pg8::gemm_phase<pg8::EpiYStats, pg8::StaticOrder, true>(F.lds + RING_OFF, g, S, E);
        if (BOTH(3)) GRID_BAR();
        if (PROBE == 11 && PROBE_PH == 3) PR_DIFF();
    }
    if (IN(4)) { if (PROBE == 11 && PROBE_PH == 4) PR_SET();
        norm_phase<0, true, 0>(F, x_p, x_s, YB, STATS, 0.5f, args.in[3], args.in[7], H, nullptr, nullptr, SA);
        if (BOTH(4)) GRID_BAR();
        if (PROBE == 11 && PROBE_PH == 4) PR_DIFF();
    }
    if (IN(5)) { if (PROBE == 11 && PROBE_PH == 5) PR_SET();
        pg8::Gemm g = pg8::gemm_rm((const char*)H + D * 2, WIN, D * 4, D * 2, D * 2);   pg8::MixOrder S; S.init(M, DIN, F.G, (int)blockIdx.x, 4, 1);
        pg8::EpiZ E{ZB, DIN, (2 * DA) / 256, SA};
        pg8::gemm_phase<pg8::EpiZ, pg8::MixOrder, true>(F.lds + RING_OFF, g, S, E);
        if (BOTH(5)) GRID_BAR();
        if (PROBE == 11 && PROBE_PH == 5) PR_DIFF();
    }
    if (IN(6)) { if (PROBE == 11 && PROBE_PH == 6) PR_SET();
        constexpr int NUNITS = (M / CH) * NH;
        const int per = (NUNITS + F.G - 1) / F.G;
        { const int ua = F.vcu * per, ub = (ua + per) < NUNITS ? (ua + per) : NUNITS; spatial_units(F, ua, ub, ZB, WSP, args.in[11], args.in[12], YCAT); }
        constexpr int NSTRIPS = M / 8;
        for (int sp = F.vcu * 2 + (F.tid >> 8); sp < NSTRIPS; sp += F.G * 2) { const int cg = F.tid & 255;
            switch (cg >> 6) { case 0: pool_strip8<1>(ZB, PB, sp, cg); break; case 1: pool_strip8<2>(ZB, PB, sp, cg); break; case 2: pool_strip8<4>(ZB, PB, sp, cg); break; default: pool_strip8<8>(ZB, PB, sp, cg); break; } }
        if (BOTH(6)) GRID_BAR();
        if (PROBE == 11 && PROBE_PH == 6) PR_DIFF();
    }
    if (IN(7)) { if (PROBE == 11 && PROBE_PH == 7) PR_SET();
        pg8::Gemm g = pg8::gemm_rm(PB, WPT, DB * 2, DPG * 2, DPG * 2, DPG * 2); pg8::StaticOrder S; S.init(M, DB, F.G, (int)blockIdx.x);
        pg8::EpiScale E{YCAT, D, DA, args.in[14]};
        pg8::gemm_phase<pg8::EpiScale, pg8::StaticOrder, true>(F.lds + RING_OFF, g, S, E);
        if (BOTH(7)) GRID_BAR();
        if (PROBE == 11 && PROBE_PH == 7) PR_DIFF();
    }
    if (IN(8)) { if (PROBE == 11 && PROBE_PH == 8) PR_SET();
        pg8::Gemm g = pg8::gemm_rm(YCAT, WOUT, D * 2, D * 2, D * 2); pg8::StaticOrder S; S.init(M, D, F.G, (int)blockIdx.x, 4);
        pg8::EpiYStats E{YB, D, STATS};
        pg8::gemm_phase<pg8::EpiYStats, pg8::StaticOrder, true>(F.lds + RING_OFF, g, S, E);
        if (BOTH(8)) GRID_BAR();
        if (PROBE == 11 && PROBE_PH == 8) PR_DIFF();
    }
    if (IN(9)) { if (PROBE == 11 && PROBE_PH == 9) PR_SET();
        norm_phase<2, false, 1>(F, nullptr, nullptr, YB, STATS, 1.0f, args.in[8], args.in[16], H, nullptr, AQ, SA);
        if (BOTH(9)) GRID_BAR();
        if (PROBE == 11 && PROBE_PH == 9) PR_DIFF();
    }
    if (IN(10)) { if (PROBE == 11 && PROBE_PH == 10) PR_SET();
        pg8::Gemm g = pg8::gemm_rm(AQ, WGU2, D, D, D); pg8::StaticOrder S; S.init(M, NGU, F.G, (int)blockIdx.x, WGM_GU);
        pg8::EpiSwiGLUQ E{HID, FF, SA, SW2};
        pg8::gemm_phase<pg8::EpiSwiGLUQ, pg8::StaticOrder, true>(F.lds + RING_OFF, g, S, E);
        if (WD2_IN_P10) {
            unsigned* qhead = (unsigned*)(F.ctl + CW_QUEUE3);
            unsigned nxt = 0u; int tpar = 0;
            if (F.tid == 0) nxt = __hip_atomic_fetch_add(qhead, 1u, RLX_AGENT);
            for (;;) {
                if (F.tid == 0) tkt[tpar] = nxt;
                LDS_WAIT(); __syncthreads();
                const unsigned cur = tkt[tpar]; tpar ^= 1;
                if (cur >= (unsigned)NC_D2) break;
                if (F.tid == 0) nxt = __hip_atomic_fetch_add(qhead, 1u, RLX_AGENT);
                tr_chunk(NCT - NC_D2 + (int)cur);
            }
        }
        if (BOTH(10)) GRID_BAR();
        if (PROBE == 11 && PROBE_PH == 10) PR_DIFF();
    }
    if (IN(11)) { if (PROBE == 11 && PROBE_PH == 11) PR_SET();
        pg8::Gemm g = pg8::gemm_tiled(HID, WD2, FF * 2); pg8::StaticOrder S; S.init(M, D, F.G, (int)blockIdx.x, WGM_DOWN, REV_DOWN);
        pg8::EpiYStats E{YB, D, STATS};
        pg8::gemm_phase<pg8::EpiYStats, pg8::StaticOrder, true>(F.lds + RING_OFF, g, S, E);
        if (BOTH(11)) GRID_BAR();
        if (PROBE == 11 && PROBE_PH == 11) PR_DIFF();
    }
    if (IN(12)) { if (PROBE == 11 && PROBE_PH == 12) PR_SET();
        norm_phase<1, false, 0>(F, nullptr, nullptr, YB, STATS, 0.5f, args.in[17], args.in[21], H, nullptr, nullptr, nullptr);
    }
    if (PROBE == 9 || PROBE == 10 || PROBE == 11) {
        GRID_BAR();
        if (blockIdx.x == 0 && F.tid == 0) { const unsigned long long t0 = __builtin_amdgcn_s_memrealtime(); const unsigned long long pm = pr[0]; const unsigned long long lim = pm < 500000ull ? pm : 500000ull; while (__builtin_amdgcn_s_memrealtime() - t0 < lim) __builtin_amdgcn_s_sleep(8); }
    }
    if (PROBE == 6 || PROBE == 12) {
        if (F.tid == 0) atomicAdd((unsigned long long*)(F.ctl + CW_PROBE), (unsigned long long)pr[1]);
        GRID_BAR();
        if (blockIdx.x == 0 && F.tid == 0) { const unsigned long long tot = __hip_atomic_load((unsigned long long*)(F.ctl + CW_PROBE), RLX_AGENT) / (unsigned long long)F.G;
            const unsigned long long t0 = __builtin_amdgcn_s_memrealtime(); const unsigned long long lim = tot < 500000ull ? tot : 500000ull; while (__builtin_amdgcn_s_memrealtime() - t0 < lim) __builtin_amdgcn_s_sleep(8); }
    }
#undef IN
#undef BOTH
#undef GRID_BAR
}

extern "C" void kernel_launch(void* const* d_in, const int* in_sizes, int n_in, void* d_out, int out_size, void* d_ws, size_t ws_size, hipStream_t stream) {
    static int grid = 0;
    if (grid == 0) {
        if (n_in != 22 || in_sizes[0] != M_PROMPT * D || out_size != M * D || ws_size < WS_END) {
            fprintf(stderr, "kernel_launch: shape/workspace mismatch: n_in %d in0 %d out %d ws %zu (need %zu); nothing launched\n", n_in, n_in > 0 ? in_sizes[0] : -1, out_size, ws_size, (size_t)WS_END); grid = -1; return; }
        int dev = 0, cus = 0, per_cu = 0;
        if (hipGetDevice(&dev) != hipSuccess || hipDeviceGetAttribute(&cus, hipDeviceAttributeMultiprocessorCount, dev) != hipSuccess) { fprintf(stderr, "kernel_launch: device query failed\n"); grid = -1; return; }
        if (hipFuncSetAttribute((const void*)mk_fwd, hipFuncAttributeMaxDynamicSharedMemorySize, LDS_BYTES) != hipSuccess) { fprintf(stderr, "kernel_launch: hipFuncSetAttribute failed\n"); grid = -1; return; }
        if (hipOccupancyMaxActiveBlocksPerMultiprocessor(&per_cu, (const void*)mk_fwd, NWAVES * 64, LDS_BYTES) != hipSuccess || per_cu < 1) {
            fprintf(stderr, "kernel_launch: occupancy query reports %d workgroups per CU\n", per_cu); }
        (void)hipGetLastError();
        grid = cus;
    }
    if (grid < 0) return;
    if (hipMemsetAsync((char*)d_ws + WS_CTL, 0, CTL_ZERO_BYTES, stream) != hipSuccess) { fprintf(stderr, "kernel_launch: memset failed\n"); return; }
    Args a{};
    for (int i = 0; i < 22; ++i) a.in[i] = (const float*)d_in[i];
    a.out = (float*)d_out; a.ws = (unsigned char*)d_ws;
    if (N_LAUNCHES == 1) { a.ph_lo = 0; a.ph_hi = N_PHASES; hipLaunchKernelGGL(mk_fwd, dim3(grid), dim3(NWAVES * 64), LDS_BYTES, stream, a); }
    else for (int li = 0; li < N_PHASES; ++li) { a.ph_lo = li; a.ph_hi = li + 1; hipLaunchKernelGGL(mk_fwd, dim3(grid), dim3(NWAVES * 64), LDS_BYTES, stream, a); }
    const hipError_t le = hipPeekAtLastError();
    if (le != hipSuccess) fprintf(stderr, "kernel_launch: launch failed: %s\n", hipGetErrorName(le));
}
```

```cpp
#include <hip/hip_runtime.h>
#include <cstdio>
#include <cstdint>

namespace pg8 {
#define PG8_LAS __attribute__((address_space(3)))
typedef unsigned short bf16_t;
typedef short bf16x8 __attribute__((ext_vector_type(8)));
typedef float f32x4 __attribute__((ext_vector_type(4)));
typedef float f32x2 __attribute__((ext_vector_type(2)));
typedef unsigned u32x4 __attribute__((ext_vector_type(4)));
typedef unsigned u32x2 __attribute__((ext_vector_type(2)));
typedef int i32x4 __attribute__((ext_vector_type(4)));
constexpr int BM = 256, BK = 64, HALF = 128, HTB = HALF * BK * 2  , STAGE_BYTES = 8 * HTB, NXCD = 8, WGM = 8;

__host__ __device__ __forceinline__ int lds_byte(int r, int c) { const int st = (r >> 4) * 2 + (c >> 5), rr = r & 15, cc = c & 31, ob = rr * 64 + cc * 2; return st * 1024 + (ob ^ (((ob >> 9) & 1) << 5)); }
__host__ __device__ __forceinline__ void stage_rc(int b, int& R, int& C) { const int st = b / 1024, sb = b % 1024, swz = sb ^ (((sb >> 9) & 1) << 5); R = (st >> 1) * 16 + swz / 64; C = (st & 1) * 32 + (swz % 64) / 2; }
__host__ __device__ __forceinline__ int perm32(int rho) { const int n = rho >> 4, i = rho & 15; return 8 * (i >> 2) + 4 * n + (i & 3); }

struct Unit { int pm, pn; };
struct Gemm { const void* A; const void* Bt; int ldaB, ldbB, KB, a_cbytes, kstepA, kstepB; size_t tstepA, tstepB; };
__host__ __device__ __forceinline__ Gemm gemm_rm(const void* A, const void* Bt, int ldaB, int ldbB, int KB, int a_cbytes = 0) { return Gemm{A, Bt, ldaB, ldbB, KB, a_cbytes, 128, 128, (size_t)256 * ldaB, (size_t)256 * ldbB}; }
constexpr int TILE_BYTES = 32768;
__host__ __device__ __forceinline__ Gemm gemm_tiled(const void* A, const void* Bt, int KB, int a_panel_tiles = 0) { return Gemm{A, Bt, 128, 128, KB, 0, TILE_BYTES, TILE_BYTES, a_panel_tiles ? (size_t)a_panel_tiles * TILE_BYTES : (size_t)256 * KB, (size_t)256 * KB}; }

struct StaticOrder {
    int nM, nN, nwg, G, c, wgm, rev;
    __host__ __device__ void init(int M, int N, int G_, int c_, int wgm_ = WGM, int rev_ = 0) { nM = M / BM; nN = N / BM; nwg = nM * nN; G = G_; c = c_; wgm = wgm_; rev = rev_; }
    __host__ __device__ bool next(int i, Unit& u) const {
        const long L = (long)i * G + c; if (L >= nwg) return false;
        int wgid = (int)L; { const int q = nwg / NXCD, r = nwg % NXCD, xcd = wgid % NXCD, cnt = xcd < r ? q + 1 : q; int off = wgid / NXCD; if (rev) off = cnt - 1 - off; wgid = (xcd < r ? xcd * (q + 1) : r * (q + 1) + (xcd - r) * q) + off; }
        const int nig = wgm * nN, gid = wgid / nig, fm = gid * wgm, gsz = (nM - fm) < wgm ? (nM - fm) : wgm;
        u.pm = fm + ((wgid % nig) % gsz); u.pn = (wgid % nig) / gsz; return true;
    }
    __device__ __forceinline__ void a_ready(const Unit&) const {}
    __device__ __forceinline__ void done(const Unit&) const {}
};

struct MixOrder : StaticOrder {
    __device__ bool next(int i, Unit& u) const { if (!StaticOrder::next(i, u)) return false; const int p = u.pn, q = p / 3, r = p - 3 * q; u.pn = (r < 2) ? 2 * q + r : 16 + q; return true; }
};
__device__ __forceinline__ unsigned cvt_pk_bf16(float lo, float hi) { unsigned r; asm volatile("v_cvt_pk_bf16_f32 %0, %1, %2" : "=v"(r) : "v"(lo), "v"(hi)); return r; }
__device__ __forceinline__ f32x2 gelu_pk(f32x2 v) {
    const f32x2 av = __builtin_elementwise_abs(v), d = av * 0.2316418882f + 1.0f;
    f32x2 t; t.x = __builtin_amdgcn_rcpf(d.x); t.y = __builtin_amdgcn_rcpf(d.y);
    f32x2 q = t * 0.5307027145f + (-0.7265760135f); q = q * t + 0.7107068705f; q = q * t + (-0.142248368f); q = q * t + 0.127414796f; q = q * t;
    const f32x2 s = (v * v) * (-0.72134752044f);
    f32x2 e; e.x = __builtin_amdgcn_exp2f(s.x); e.y = __builtin_amdgcn_exp2f(s.y);
    const f32x2 m = v * (q * e), r = v - m;
    f32x2 o; o.x = v.x < 0.f ? m.x : r.x; o.y = v.y < 0.f ? m.y : r.y; return o;
}
__device__ __forceinline__ float silu_f(float g) { return g * __builtin_amdgcn_rcpf(1.0f + __builtin_amdgcn_exp2f(-1.44269504f * g)); }

struct EpiSwiGLU {
    static constexpr bool PERM = true, AFTER_DRAIN = false, I8 = false; typedef f32x4 acc_t;
    bf16_t* O; int ldc;
    __device__ __forceinline__ void operator()(const f32x4 (&acc)[2][2][4][2], const Unit& u, int wr, int wc, int fr, int fq) const {
        const int row0 = u.pm * BM + wr * 64 + fr, col0 = u.pn * HALF + wc * 32 + 8 * fq;
#pragma unroll
        for (int ai = 0; ai < 2; ++ai)
#pragma unroll
            for (int m = 0; m < 4; ++m) { bf16_t* rowp = O + (size_t)(row0 + ai * HALF + m * 16) * ldc + col0;
                const f32x4 g0 = acc[ai][0][m][0], g1 = acc[ai][0][m][1], u0 = acc[ai][1][m][0], u1 = acc[ai][1][m][1];
                u32x4 w;
                w.x = cvt_pk_bf16(silu_f(g0[0]) * u0[0], silu_f(g0[1]) * u0[1]); w.y = cvt_pk_bf16(silu_f(g0[2]) * u0[2], silu_f(g0[3]) * u0[3]);
                w.z = cvt_pk_bf16(silu_f(g1[0]) * u1[0], silu_f(g1[1]) * u1[1]); w.w = cvt_pk_bf16(silu_f(g1[2]) * u1[2], silu_f(g1[3]) * u1[3]);
                *(u32x4*)rowp = w; }
    }
};
struct EpiSwiGLUQ {
    static constexpr bool PERM = true, AFTER_DRAIN = false, I8 = true; typedef i32x4 acc_t;
    bf16_t* O; int ldc; const float* sa; const float* sw;
    __device__ __forceinline__ static f32x4 act4(const i32x4 G, const i32x4 U, const f32x4 kL, const f32x4 kP) {
        const f32x4 gf = __builtin_convertvector(G, f32x4), uf = __builtin_convertvector(U, f32x4);
        const f32x4 t = gf * kL; f32x4 d;
        d.x = __builtin_amdgcn_exp2f(t.x); d.y = __builtin_amdgcn_exp2f(t.y); d.z = __builtin_amdgcn_exp2f(t.z); d.w = __builtin_amdgcn_exp2f(t.w);
        d = d + 1.0f; f32x4 r;
        r.x = __builtin_amdgcn_rcpf(d.x); r.y = __builtin_amdgcn_rcpf(d.y); r.z = __builtin_amdgcn_rcpf(d.z); r.w = __builtin_amdgcn_rcpf(d.w);
        return ((gf * uf) * kP) * r;
    }
    __device__ __forceinline__ void operator()(const i32x4 (&acc)[2][2][4][2], const Unit& u, int wr, int wc, int fr, int fq) const {
        const int row0 = u.pm * BM + wr * 64 + fr;
        const float* swp = sw + u.pn * BM + wc * 32 + 8 * fq;
        const f32x4 sg0 = *(const f32x4*)(swp), sg1 = *(const f32x4*)(swp + 4), su0 = *(const f32x4*)(swp + HALF), su1 = *(const f32x4*)(swp + HALF + 4);
        const f32x4 gu0 = sg0 * su0, gu1 = sg1 * su1;
        float sr[2][4];
#pragma unroll
        for (int ai = 0; ai < 2; ++ai)
#pragma unroll
            for (int m = 0; m < 4; ++m) sr[ai][m] = sa[row0 + ai * HALF + m * 16];
#pragma unroll
        for (int ai = 0; ai < 2; ++ai)
#pragma unroll
            for (int m = 0; m < 4; ++m) { const float s = sr[ai][m];
                bf16_t* rowp = (bf16_t*)((char*)O + ((size_t)u.pm * (ldc / 64) + 2 * u.pn + (wc >> 1)) * TILE_BYTES + (wr * 64 + fr + ai * HALF + m * 16) * 128 + ((wc & 1) * 32 + 8 * fq) * 2);
                const float sl = s * -1.44269504f, ss = s * s;
                const f32x4 o0 = act4(acc[ai][0][m][0], acc[ai][1][m][0], sg0 * sl, gu0 * ss), o1 = act4(acc[ai][0][m][1], acc[ai][1][m][1], sg1 * sl, gu1 * ss);
                u32x4 w; w.x = cvt_pk_bf16(o0[0], o0[1]); w.y = cvt_pk_bf16(o0[2], o0[3]); w.z = cvt_pk_bf16(o1[0], o1[1]); w.w = cvt_pk_bf16(o1[2], o1[3]);
                __builtin_nontemporal_store(w, (u32x4*)rowp); }
    }
};
struct EpiYStats {
    static constexpr bool PERM = true, AFTER_DRAIN = false, I8 = false; typedef f32x4 acc_t;
    bf16_t* O; int ldc; float* stats;
    __device__ __forceinline__ void operator()(const f32x4 (&acc)[2][2][4][2], const Unit& u, int wr, int wc, int fr, int fq) const {
        const int row0 = u.pm * BM + wr * 64 + fr, col0 = u.pn * BM + wc * 32 + 8 * fq;
#pragma unroll
        for (int ai = 0; ai < 2; ++ai)
#pragma unroll
            for (int m = 0; m < 4; ++m) { const int row = row0 + ai * HALF + m * 16; bf16_t* rowp = O + (size_t)row * ldc + col0; float ss = 0.f;
#pragma unroll
                for (int bj = 0; bj < 2; ++bj) { const f32x4 v0 = acc[ai][bj][m][0], v1 = acc[ai][bj][m][1];
                    ss += (v0[0] * v0[0] + v0[1] * v0[1]) + (v0[2] * v0[2] + v0[3] * v0[3]) + (v1[0] * v1[0] + v1[1] * v1[1]) + (v1[2] * v1[2] + v1[3] * v1[3]);
                    u32x4 w; w.x = cvt_pk_bf16(v0[0], v0[1]); w.y = cvt_pk_bf16(v0[2], v0[3]); w.z = cvt_pk_bf16(v1[0], v1[1]); w.w = cvt_pk_bf16(v1[2], v1[3]);
                    *(u32x4*)(rowp + bj * HALF) = w; }
                ss += __shfl_xor(ss, 16); ss += __shfl_xor(ss, 32);
                if (fq == 0) stats[(size_t)row * 64 + u.pn * 4 + wc] = ss; }
    }
};
struct EpiZ {
    static constexpr bool PERM = true, AFTER_DRAIN = false, I8 = false; typedef f32x4 acc_t;
    bf16_t* O; int ldc; int gelu_tiles; const float* rs;
    __device__ __forceinline__ void operator()(const f32x4 (&acc)[2][2][4][2], const Unit& u, int wr, int wc, int fr, int fq) const {
        const int row0 = u.pm * BM + wr * 64 + fr, col0 = u.pn * BM + wc * 32 + 8 * fq; const bool act = u.pn < gelu_tiles;
        float sr[2][4];
#pragma unroll
        for (int ai = 0; ai < 2; ++ai)
#pragma unroll
            for (int m = 0; m < 4; ++m) sr[ai][m] = rs[row0 + ai * HALF + m * 16];
#pragma unroll
        for (int ai = 0; ai < 2; ++ai)
#pragma unroll
            for (int m = 0; m < 4; ++m) { bf16_t* rowp = O + (size_t)(row0 + ai * HALF + m * 16) * ldc + col0; const float s = sr[ai][m];
#pragma unroll
                for (int bj = 0; bj < 2; ++bj) { f32x4 v0 = acc[ai][bj][m][0] * s, v1 = acc[ai][bj][m][1] * s;
                    if (act) { const f32x2 a = gelu_pk((f32x2){v0[0], v0[1]}), b = gelu_pk((f32x2){v0[2], v0[3]}), c = gelu_pk((f32x2){v1[0], v1[1]}), d = gelu_pk((f32x2){v1[2], v1[3]});
                        v0 = (f32x4){a.x, a.y, b.x, b.y}; v1 = (f32x4){c.x, c.y, d.x, d.y}; }
                    u32x4 w; w.x = cvt_pk_bf16(v0[0], v0[1]); w.y = cvt_pk_bf16(v0[2], v0[3]); w.z = cvt_pk_bf16(v1[0], v1[1]); w.w = cvt_pk_bf16(v1[2], v1[3]);
                    *(u32x4*)(rowp + bj * HALF) = w; } }
    }
};
struct EpiScale {
    static constexpr bool PERM = true, AFTER_DRAIN = false, I8 = false; typedef f32x4 acc_t;
    bf16_t* O; int ldc; int ocol; const float* scale;
    __device__ __forceinline__ void operator()(const f32x4 (&acc)[2][2][4][2], const Unit& u, int wr, int wc, int fr, int fq) const {
        const int row0 = u.pm * BM + wr * 64 + fr, col0 = u.pn * BM + wc * 32 + 8 * fq;
        f32x4 sv[2][2];
#pragma unroll
        for (int bj = 0; bj < 2; ++bj)
#pragma unroll
            for (int n = 0; n < 2; ++n) sv[bj][n] = *(const f32x4*)(scale + col0 + bj * HALF + 4 * n);
#pragma unroll
        for (int ai = 0; ai < 2; ++ai)
#pragma unroll
            for (int m = 0; m < 4; ++m) { bf16_t* rowp = O + (size_t)(row0 + ai * HALF + m * 16) * ldc + ocol + col0;
#pragma unroll
                for (int bj = 0; bj < 2; ++bj) { const f32x4 v0 = acc[ai][bj][m][0] * sv[bj][0], v1 = acc[ai][bj][m][1] * sv[bj][1];
                    u32x4 w; w.x = cvt_pk_bf16(v0[0], v0[1]); w.y = cvt_pk_bf16(v0[2], v0[3]); w.z = cvt_pk_bf16(v1[0], v1[1]); w.w = cvt_pk_bf16(v1[2], v1[3]);
                    *(u32x4*)(rowp + bj * HALF) = w; } }
    }
};

template <bool I8> __device__ __forceinline__ f32x4 mma1(i32x4 b, i32x4 a, f32x4 c) { return __builtin_amdgcn_mfma_f32_16x16x32_bf16(__builtin_bit_cast(bf16x8, b), __builtin_bit_cast(bf16x8, a), c, 0, 0, 0); }
template <bool I8> __device__ __forceinline__ i32x4 mma1(i32x4 b, i32x4 a, i32x4 c) { return __builtin_amdgcn_mfma_i32_16x16x64_i8(b, a, c, 0, 0, 0); }
template <class Epi, class Sched, bool ALIGN_EPI>
__device__ __forceinline__ void gemm_phase(PG8_LAS unsigned char* lds, const Gemm g, const Sched& S, const Epi& E) {
    const int tid = threadIdx.x, wid = __builtin_amdgcn_readfirstlane(tid >> 6), lane = tid & 63, wr = wid >> 2, wc = wid & 3, fr = lane & 15, fq = lane >> 4;
    const int nt = g.KB / (BK * 2);
    typedef typename Epi::acc_t acc_t; typedef i32x4 frag_t;
    unsigned voffA[2], voffB[2];
#pragma unroll
    for (int i = 0; i < 2; ++i) { int R, C; stage_rc(tid * 16 + i * 8192, R, C); const int Rb = Epi::PERM ? ((R & ~31) + perm32(R & 31)) : R;
        voffA[i] = (unsigned)(R * g.ldaB + C * 2); voffB[i] = (unsigned)(Rb * g.ldbB + C * 2); }
    const size_t kstepA = (size_t)g.kstepA, kstepB = (size_t)g.kstepB;
    const size_t hstepA = (size_t)HALF * g.ldaB, hstepB = (size_t)HALF * g.ldbB;
    const size_t tstepA = g.tstepA, tstepB = g.tstepB;
    const size_t acstep = (size_t)g.a_cbytes;
    const unsigned ldsw = (unsigned)wid * 1024u;
    const int aoff = lds_byte(wr * 64 + fr, fq * 8), boff = lds_byte(wc * 32 + fr, fq * 8);
#define PG8_SA(b, h) (((b) * 2 + (h)) * HTB)
#define PG8_SB(b, h) ((4 + (b) * 2 + (h)) * HTB)
#define PG8_STAGE(bufoff, gbase, voff) do { const char* _gb = (const char*)(gbase); asm volatile("" : "+s"(_gb)); _Pragma("unroll") for (int _i = 0; _i < 2; ++_i) { const unsigned _vo = (voff)[_i];     \
        __builtin_amdgcn_global_load_lds((const unsigned*)(_gb + _vo), (PG8_LAS unsigned*)(lds + (bufoff) + ldsw + _i * 8192), 16, 0, 0); } } while (0)
#define PG8_LDA(dst, b, h) do { _Pragma("unroll") for (int m = 0; m < 4; ++m) _Pragma("unroll") for (int k = 0; k < 2; ++k) dst[m][k] = *(const PG8_LAS frag_t*)(lds + PG8_SA(b, h) + aoff + m * 2048 + k * 1024); } while (0)
#define PG8_LDB(dst, b, h) do { _Pragma("unroll") for (int n = 0; n < 2; ++n) _Pragma("unroll") for (int k = 0; k < 2; ++k) dst[n][k] = *(const PG8_LAS frag_t*)(lds + PG8_SB(b, h) + boff + n * 2048 + k * 1024); } while (0)
#define PG8_MMA(ai, bj, At, Bt) do { __builtin_amdgcn_s_setprio(1); _Pragma("unroll") for (int m = 0; m < 4; ++m) _Pragma("unroll") for (int n = 0; n < 2; ++n) _Pragma("unroll") for (int k = 0; k < 2; ++k) \
        acc[ai][bj][m][n] = mma1<Epi::I8>(Bt[n][k], At[m][k], acc[ai][bj][m][n]); __builtin_amdgcn_s_setprio(0); } while (0)
#define PG8_WAIT_V(n) asm volatile("s_waitcnt vmcnt(" #n ")" ::: "memory")
#define PG8_WAIT_L(n) asm volatile("s_waitcnt lgkmcnt(" #n ")" ::: "memory")
#define PG8_BAR __builtin_amdgcn_s_barrier()
#define PG8_SCHED __builtin_amdgcn_sched_barrier(0)
#define PG8_UA(u) ((const char*)g.A + (size_t)(u).pm * tstepA + (size_t)((u).pn >> 1) * acstep)
#define PG8_UB(u) ((const char*)g.Bt + (size_t)(u).pn * tstepB)
    Unit cur, nxt; int ui = 0;
    if (!S.next(0, cur)) return;
    acc_t acc[2][2][4][2];
#pragma unroll
    for (int a = 0; a < 2; ++a)
#pragma unroll
        for (int b = 0; b < 2; ++b)
#pragma unroll
            for (int m = 0; m < 4; ++m)
#pragma unroll
                for (int n = 0; n < 2; ++n) acc[a][b][m][n] = (acc_t){0, 0, 0, 0};
    frag_t At[4][2], B0[2][2], B1[2][2];
    const char* cA = PG8_UA(cur); const char* cB = PG8_UB(cur);
    S.a_ready(cur);
    PG8_STAGE(PG8_SB(0, 0), cB, voffB); PG8_STAGE(PG8_SB(0, 1), cB + hstepB, voffB); PG8_STAGE(PG8_SA(0, 0), cA, voffA); PG8_STAGE(PG8_SA(0, 1), cA + hstepA, voffA);
    if (wr == 1) PG8_BAR;
    PG8_WAIT_V(2); PG8_BAR;
    PG8_STAGE(PG8_SB(1, 0), cB + kstepB, voffB); PG8_STAGE(PG8_SA(1, 0), cA + kstepA, voffA); PG8_STAGE(PG8_SB(1, 1), cB + hstepB + kstepB, voffB);
    PG8_WAIT_V(6); PG8_BAR;
    for (;;) {
        const bool has_next = S.next(ui + 1, nxt);
        const char* nA = has_next ? PG8_UA(nxt) : cA; const char* nB = has_next ? PG8_UB(nxt) : cB;
        for (int t = 0; t < nt; t += 2) {
            asm volatile("" : "+v"(voffA[0]), "+v"(voffA[1]), "+v"(voffB[0]), "+v"(voffB[1]));
            const bool last = (t == nt - 2);
            const char* a1 = cA + (size_t)(t + 1) * kstepA;
            const char* a2 = last ? nA : cA + (size_t)(t + 2) * kstepA; const char* b2 = last ? nB : cB + (size_t)(t + 2) * kstepB;
            const char* a3 = a2 + kstepA; const char* b3 = b2 + kstepB;
            if (last && has_next) S.a_ready(nxt);
            PG8_LDB(B0, 0, 0); PG8_LDB(B1, 0, 1); PG8_SCHED; PG8_LDA(At, 0, 0); PG8_STAGE(PG8_SA(1, 1), a1 + hstepA, voffA);
            PG8_WAIT_V(8); PG8_WAIT_L(0); PG8_BAR; PG8_MMA(0, 0, At, B0); PG8_MMA(0, 1, At, B1); PG8_BAR; PG8_SCHED;
            PG8_LDA(At, 0, 1); PG8_STAGE(PG8_SB(0, 0), b2, voffB); PG8_STAGE(PG8_SB(0, 1), b2 + hstepB, voffB); PG8_STAGE(PG8_SA(0, 0), a2, voffA);
            PG8_WAIT_V(8); PG8_WAIT_L(0); PG8_BAR; PG8_MMA(1, 0, At, B0); PG8_MMA(1, 1, At, B1); PG8_BAR; PG8_SCHED;
            PG8_LDB(B0, 1, 0); PG8_LDB(B1, 1, 1); PG8_SCHED; PG8_LDA(At, 1, 0); PG8_STAGE(PG8_SA(0, 1), a2 + hstepA, voffA);
            PG8_WAIT_V(8); PG8_WAIT_L(0); PG8_BAR; PG8_MMA(0, 0, At, B0); PG8_MMA(0, 1, At, B1); PG8_BAR; PG8_SCHED;
            PG8_LDA(At, 1, 1); PG8_STAGE(PG8_SB(1, 0), b3, voffB); PG8_STAGE(PG8_SB(1, 1), b3 + hstepB, voffB); PG8_STAGE(PG8_SA(1, 0), a3, voffA);
            PG8_WAIT_V(8); PG8_WAIT_L(0); PG8_BAR; PG8_MMA(1, 0, At, B0); PG8_MMA(1, 1, At, B1); PG8_BAR; PG8_SCHED;
        }
        if constexpr (ALIGN_EPI) { if (wr == 0) PG8_BAR; }
        E(acc, cur, wr, wc, fr, fq); S.done(cur);
        if (!has_next) break;
#pragma unroll
        for (int a = 0; a < 2; ++a)
#pragma unroll
            for (int b = 0; b < 2; ++b)
#pragma unroll
                for (int m = 0; m < 4; ++m)
#pragma unroll
                    for (int n = 0; n < 2; ++n) acc[a][b][m][n] = (acc_t){0, 0, 0, 0};
        cur = nxt; cA = nA; cB = nB; ++ui;
        if constexpr (ALIGN_EPI) { if (wr == 1) PG8_BAR; }
    }
    PG8_WAIT_V(0);
    if constexpr (!ALIGN_EPI) { if (wr == 0) PG8_BAR; }
    PG8_BAR;
#undef PG8_SA
#undef PG8_SB
#undef PG8_STAGE
#undef PG8_LDA
#undef PG8_LDB
#undef PG8_MMA
#undef PG8_WAIT_V
#undef PG8_WAIT_L
#undef PG8_BAR
#undef PG8_SCHED
#undef PG8_UA
#undef PG8_UB
}
}

constexpr int NWAVES = 8;
#ifndef MK_N_LAUNCHES
#define MK_N_LAUNCHES 1
#endif
constexpr int N_PHASES = 13;
#ifndef WGM_GU
#define WGM_GU 4
#endif
#ifndef BG_IN_P2
#define BG_IN_P2 1
#endif
#ifndef WD2_IN_P10
#define WD2_IN_P10 1
#endif
#ifndef TEAM_SEAMS
#define TEAM_SEAMS 1
#endif
#ifndef BG_TR
#define BG_TR 0
#endif
#ifndef NBG
#define NBG 0
#endif
#ifndef REV_DOWN
#define REV_DOWN 1
#endif
#ifndef WGM_DOWN
#define WGM_DOWN 4
#endif
#ifndef PROBE
#define PROBE 0
#endif
#ifndef PROBE_PH
#define PROBE_PH 0
#endif
constexpr int N_LAUNCHES = MK_N_LAUNCHES;
static_assert(N_LAUNCHES == 1 || N_LAUNCHES == N_PHASES, "MK_N_LAUNCHES is 1 or 13");

constexpr int M = 24576, M_PROMPT = 16384, SEQ_P = 8192, SEQ_S = 2048;
constexpr int D = 4096, FF = 11008, NGU = 2 * FF, DIN = 6144, DA = 2048, DB = 2048, NH = 16, HD = 128, CH = 128, DPG = 512;
constexpr float EPS = 1e-6f;

constexpr size_t MiB = 1u << 20;
constexpr size_t WS_CTL = 0, CTL_ZERO_BYTES = 64 * 1024;
constexpr size_t WS_STATS = 1 * MiB;
constexpr size_t WS_SA = 7 * MiB, WS_SW1 = 7 * MiB + 256 * 1024, WS_SW2 = 7 * MiB + 512 * 1024;
constexpr size_t WGU_PS = 1 * MiB + 64 * 1024;
constexpr size_t WS_WGU1 = 8 * MiB, WS_WD1 = 100 * MiB, WS_WGU2 = 186 * MiB, WS_WD2 = 278 * MiB;
constexpr size_t WS_WIN = 364 * MiB, WS_WOUT = 412 * MiB, WS_WSP = 444 * MiB, WS_WPT = 445 * MiB;
constexpr size_t WS_A = 448 * MiB;
constexpr size_t WS_HID = 640 * MiB;
constexpr size_t WS_Z = WS_HID, WS_YCAT = WS_HID + 288 * MiB;
constexpr int HID_PT = 192;
constexpr size_t WS_Y = 1216 * MiB;
constexpr size_t WS_END = 1408 * MiB;
static_assert((4096 + 3456) * 4 <= (int)CTL_ZERO_BYTES && WS_STATS + (size_t)M * 64 * 4 <= WS_SA && WS_SA + (size_t)M * 4 <= WS_SW1 && WS_SW1 + NGU * 4 <= WS_SW2 && WS_SW2 + NGU * 4 <= WS_WGU1, "ws map 0");
static_assert(WS_WGU1 + (size_t)(NGU / 256) * WGU_PS <= WS_WD1 && WGU_PS >= (size_t)256 * D && WS_WD1 + (size_t)D * FF * 2 <= WS_WGU2 && WS_WGU2 + (size_t)(NGU / 256) * WGU_PS <= WS_WD2 && WS_WD2 + (size_t)D * FF * 2 <= WS_WIN, "ws map 1");
static_assert(WS_WIN + (size_t)DIN * D * 2 <= WS_WOUT && WS_WOUT + (size_t)D * D * 2 <= WS_WSP && WS_WSP + (size_t)NH * CH * CH * 2 <= WS_WPT && WS_WPT + (size_t)DB * DPG * 2 <= WS_A, "ws map 2");
static_assert(WS_A + (size_t)M * D * 2 <= WS_HID && WS_HID + (size_t)(M / 256) * HID_PT * 32768 <= WS_Y && HID_PT >= FF / 64 && WS_Y + (size_t)M * D * 2 <= WS_END && WS_YCAT + (size_t)M * D * 2 <= WS_Y && WS_Z + (size_t)M * DIN * 2 <= WS_YCAT, "ws map 3");
constexpr int CW_TMO = 0, CW_CODE = 1;
constexpr int CW_BAR = 4096, CW_BAR_END = CW_BAR + 3456;
constexpr int CW_PROBE = 512, CW_QUEUE = 640, CW_QUEUE2 = 704, CW_QUEUE3 = 768, CW_TEAM = 1024;

constexpr int RING_OFF = 0, RING_BYTES = 131072;
constexpr int LDSCTL_OFF = RING_BYTES, MISC_OFF = LDSCTL_OFF + 320;
constexpr int LDSX_OFF = LDSCTL_OFF + 1024;
constexpr int LDS_BYTES = 147456;
static_assert(MISC_OFF + 128 <= LDSX_OFF && LDSX_OFF + 4096 <= LDS_BYTES, "LDS map");

#define GAS __attribute__((address_space(1)))
#define LAS __attribute__((address_space(3)))
typedef unsigned short bf16;
typedef unsigned v4u __attribute__((ext_vector_type(4)));
typedef unsigned v2u __attribute__((ext_vector_type(2)));
typedef float f32x4 __attribute__((ext_vector_type(4)));
typedef short bf16x8 __attribute__((ext_vector_type(8)));
typedef GAS unsigned gu32;
#define RLX_AGENT __ATOMIC_RELAXED, __HIP_MEMORY_SCOPE_AGENT
#define LDS_WAIT() asm volatile("s_waitcnt lgkmcnt(0)" ::: "memory")
#define VM_WAIT() asm volatile("s_waitcnt vmcnt(0)" ::: "memory")
__device__ __forceinline__ unsigned f2bf(float f) { unsigned u = __builtin_bit_cast(unsigned, f); return (u + 0x7fffu + ((u >> 16) & 1u)) >> 16; }
__device__ __forceinline__ unsigned pk2(float lo, float hi) { return f2bf(lo) | (f2bf(hi) << 16); }
__device__ __forceinline__ float bf_lo(unsigned w) { return __builtin_bit_cast(float, w << 16); }
__device__ __forceinline__ float bf_hi(unsigned w) { return __builtin_bit_cast(float, w & 0xffff0000u); }
__device__ __forceinline__ unsigned q8(float v) { return (unsigned)(int)__builtin_rintf(v) & 255u; }
__device__ __forceinline__ unsigned pk4q(float a, float b, float c, float d) { return q8(a) | (q8(b) << 8) | (q8(c) << 16) | (q8(d) << 24); }

#define XB_TMO      128
#define XB_XCNT(j)  (256  + 64 * (j))
#define XB_XSUB(j)  (1280 + 64 * (j))
#define XB_XGEN(j)  (2304 + 64 * (j))
#define XB_TOP      3328
#define XB_TOPGEN   3392
#define XCD_BAR_WORDS 3456
#define XB_SPIN_CAP (1u << 18)

__device__ __forceinline__ unsigned xb_ld(unsigned* p)              { return __hip_atomic_load(p, __ATOMIC_RELAXED, __HIP_MEMORY_SCOPE_AGENT); }
__device__ __forceinline__ unsigned xb_add(unsigned* p, unsigned v) { return __hip_atomic_fetch_add(p, v, __ATOMIC_RELAXED, __HIP_MEMORY_SCOPE_AGENT); }
__device__ __forceinline__ unsigned xb_xcc_id() { return (unsigned)__builtin_amdgcn_s_getreg((3 << 11) | 20) & 0xFu; }
#define XB_SPIN(cond, bar) do { unsigned _sp = 0; while (cond) { __builtin_amdgcn_s_sleep(1); \
    if ((++_sp & 255u) == 0u) { if (xb_ld(&(bar)[XB_TMO])) break; if (_sp > XB_SPIN_CAP) { atomicAdd(&(bar)[XB_TMO], 1u); break; } } } } while (0)

struct XcdBarrier {
    unsigned* bar; unsigned x;
    volatile LAS unsigned* st;
};

__device__ __forceinline__ XcdBarrier xcd_barrier_post(unsigned* bar, volatile LAS unsigned* st) {
    XcdBarrier b; b.bar = bar; b.x = xb_xcc_id(); b.st = st;
    if (threadIdx.x == 0) (void)xb_add(&bar[XB_XCNT(b.x)], 1u);
    return b;
}
__device__ __forceinline__ void xcd_barrier_complete(unsigned* bar, unsigned x, unsigned& nloc, unsigned& nx) {
    const unsigned G = gridDim.x * gridDim.y * gridDim.z;
    unsigned sum, cnt, mine, sp = 0u;
    for (;;) {
        sum = 0u; cnt = 0u; mine = 0u;
#pragma unroll
        for (unsigned j = 0; j < 16; ++j) { const unsigned c = xb_ld(&bar[XB_XCNT(j)]); sum += c; cnt += (c > 0u) ? 1u : 0u; mine = (j == x) ? c : mine; }
        if (sum == G) break;
        __builtin_amdgcn_s_sleep(1);
        if ((++sp & 255u) == 0u) { if (xb_ld(&bar[XB_TMO])) break; if (sp > XB_SPIN_CAP) { atomicAdd(&bar[XB_TMO], 1u); break; } }
    }
    nloc = mine > 0u ? mine : 1u; nx = cnt > 0u ? cnt : 1u;
}

__device__ __forceinline__ void xcd_barrier(const XcdBarrier& b) {
    asm volatile("s_waitcnt vmcnt(0)" ::: "memory");
    __syncthreads();
    if (threadIdx.x == 0) {
        unsigned* bar = b.bar;
        __builtin_amdgcn_s_waitcnt(0);
        unsigned nloc = b.st[0], nx = b.st[1];
        if (nloc == 0u) { xcd_barrier_complete(bar, b.x, nloc, nx); b.st[0] = nloc; b.st[1] = nx; }
        const unsigned old = xb_add(&bar[XB_XSUB(b.x)], 1u);
        const unsigned gen = old / nloc;
        if (old + 1u == (gen + 1u) * nloc) {
            __builtin_amdgcn_fence(__ATOMIC_RELEASE, "agent");
            asm volatile("s_waitcnt vmcnt(0)" ::: "memory");
            const unsigned og = xb_add(&bar[XB_TOP], 1u);
            const unsigned tg = og / nx;
            if (og + 1u == (tg + 1u) * nx) xb_add(&bar[XB_TOPGEN], 1u);
            else XB_SPIN(xb_ld(&bar[XB_TOPGEN]) == tg, bar);
            __builtin_amdgcn_fence(__ATOMIC_ACQUIRE, "agent");
            xb_add(&bar[XB_XGEN(b.x)], 1u);
            asm volatile("s_waitcnt vmcnt(0)" ::: "memory");
        } else {
            XB_SPIN(xb_ld(&bar[XB_XGEN(b.x)]) == gen, bar);
            __builtin_amdgcn_fence(__ATOMIC_ACQUIRE, "agent");
            asm volatile("s_waitcnt vmcnt(0)" ::: "memory");
        }
    }
    __syncthreads();
}

struct Frame {
    LAS unsigned char* lds;
    volatile LAS unsigned* MISC;
    gu32* ctl;
    int tid, lane, wave;
    int vcu, G;
};

__device__ __forceinline__ float wave_sum(float v) {
#pragma unroll
    for (int o = 1; o < 64; o <<= 1) v += __shfl_xor(v, o);
    return v;
}
__device__ __forceinline__ float wave_max(float v) {
#pragma unroll
    for (int o = 1; o < 64; o <<= 1) v = fmaxf(v, __shfl_xor(v, o));
    return v;
}
template <bool TILED>
__device__ __forceinline__ void p0_transpose_item(const float* W, int K, int N, bf16* WT, int row_off, LAS float* scr, int item, int lane) {
    const int nblk = N / 32, kb = item / nblk, nb = item % nblk, k0 = 64 * kb, n0 = 32 * nb;
#pragma unroll 8
    for (int i = 0; i < 32; ++i) { const int kk = 2 * i + (lane >> 5); scr[kk * 33 + (lane & 31)] = W[(size_t)(k0 + kk) * N + n0 + (lane & 31)]; }
    LDS_WAIT(); asm volatile("" ::: "memory");
    const int c = lane & 7;
#pragma unroll
    for (int j = 0; j < 4; ++j) { const int n = (lane >> 3) + 8 * j; const LAS float* s = scr + (8 * c) * 33 + n;
        v4u o; o.x = pk2(s[0 * 33], s[1 * 33]); o.y = pk2(s[2 * 33], s[3 * 33]); o.z = pk2(s[4 * 33], s[5 * 33]); o.w = pk2(s[6 * 33], s[7 * 33]);
        if constexpr (TILED) { const int r = row_off + n0 + n;
            *(GAS v4u*)((GAS char*)WT + ((size_t)(r >> 8) * (K / 64) + kb) * 32768 + (r & 255) * 128 + 16 * c) = o; }
        else *(GAS v4u*)(WT + (size_t)(row_off + n0 + n) * K + k0 + 8 * c) = o; }
    LDS_WAIT(); asm volatile("" ::: "memory");
}
struct TJob { const float* W; bf16* WT; int K, N, row_off, tiled; const float* ks; };
__device__ __forceinline__ void tr_load(const TJob& J, int item, int lane, f32x4 (&v)[8]) {
    const int nblk = J.N / 32, kb = item / nblk, nb = item % nblk;
    const GAS f32x4* p = (const GAS f32x4*)(J.W + (size_t)(64 * kb + (lane >> 3)) * J.N + 32 * nb) + (lane & 7);
#pragma unroll
    for (int i = 0; i < 8; ++i) v[i] = __builtin_nontemporal_load(&p[(size_t)i * 8 * (J.N / 4)]);
    if (J.ks) {
        float s[8];
#pragma unroll
        for (int i = 0; i < 8; ++i) s[i] = J.ks[64 * kb + (lane >> 3) + 8 * i];
#pragma unroll
        for (int i = 0; i < 8; ++i) v[i] = v[i] * s[i];
    }
}
__device__ __forceinline__ void tr_commit(const TJob& J, int item, int lane, const f32x4 (&v)[8], LAS float* scr) {
    const int nblk = J.N / 32, kb = item / nblk, nb = item % nblk, k0 = 64 * kb, n0 = 32 * nb;
#pragma unroll
    for (int i = 0; i < 8; ++i) { LAS float* d = scr + (8 * i + (lane >> 3)) * 33 + 4 * (lane & 7); d[0] = v[i].x; d[1] = v[i].y; d[2] = v[i].z; d[3] = v[i].w; }
    LDS_WAIT(); asm volatile("" ::: "memory");
    const int c = lane & 7;
#pragma unroll
    for (int j = 0; j < 4; ++j) { const int n = (lane >> 3) + 8 * j; const LAS float* s = scr + (8 * c) * 33 + n;
        v4u o; o.x = pk2(s[0 * 33], s[1 * 33]); o.y = pk2(s[2 * 33], s[3 * 33]); o.z = pk2(s[4 * 33], s[5 * 33]); o.w = pk2(s[6 * 33], s[7 * 33]);
        const int r = J.row_off + n0 + n;
        if (J.tiled) __builtin_nontemporal_store(o, (GAS v4u*)((GAS char*)J.WT + ((size_t)(r >> 8) * (J.K / 64) + kb) * 32768 + (r & 255) * 128 + 16 * c));
        else __builtin_nontemporal_store(o, (GAS v4u*)(J.WT + (size_t)r * J.K + k0 + 8 * c)); }
    LDS_WAIT(); asm volatile("" ::: "memory");
}
__device__ __forceinline__ void p0_quant_item2(const float* W, float cm, signed char* WQ, int drow0, LAS float* scr, int kb, int n0, int lane) {
    const int k0 = 64 * kb;
#pragma unroll 8
    for (int i = 0; i < 32; ++i) { const int kk = 2 * i + (lane >> 5); scr[kk * 33 + (lane & 31)] = W[(size_t)(k0 + kk) * FF + n0 + (lane & 31)]; }
    LDS_WAIT(); asm volatile("" ::: "memory");
    const int c = lane & 3;
#pragma unroll
    for (int j = 0; j < 2; ++j) { const int n = (lane >> 2) + 16 * j; const LAS float* s = scr + (16 * c) * 33 + n;
        const float mxv = __shfl(cm, n); const float inv = mxv > 0.f ? 127.0f / mxv : 0.f;
        v4u o; o.x = pk4q(s[0 * 33] * inv, s[1 * 33] * inv, s[2 * 33] * inv, s[3 * 33] * inv); o.y = pk4q(s[4 * 33] * inv, s[5 * 33] * inv, s[6 * 33] * inv, s[7 * 33] * inv);
        o.z = pk4q(s[8 * 33] * inv, s[9 * 33] * inv, s[10 * 33] * inv, s[11 * 33] * inv); o.w = pk4q(s[12 * 33] * inv, s[13 * 33] * inv, s[14 * 33] * inv, s[15 * 33] * inv);
        *(GAS v4u*)(WQ + (size_t)(drow0 + n) * D + k0 + 16 * c) = o; }
    LDS_WAIT(); asm volatile("" ::: "memory");
}
__device__ __forceinline__ const float* x_row(const float* xp, const float* xs, int m) { return m < M_PROMPT ? xp + (size_t)m * D : xs + (size_t)(m - M_PROMPT) * D; }

__device__ __forceinline__ void quant_row_store(int lane, const f32x4 (&a)[16], signed char* qrow, float* sa) {
    float mx = 0.f;
#pragma unroll
    for (int j = 0; j < 16; ++j) mx = fmaxf(fmaxf(mx, fmaxf(fabsf(a[j].x), fabsf(a[j].y))), fmaxf(fabsf(a[j].z), fabsf(a[j].w)));
    mx = wave_max(mx);
    const float inv = mx > 0.f ? 127.0f / mx : 0.f;
    GAS unsigned* o = (GAS unsigned*)qrow + lane;
#pragma unroll
    for (int j = 0; j < 16; ++j) o[64 * j] = pk4q(a[j].x * inv, a[j].y * inv, a[j].z * inv, a[j].w * inv);
    if (lane == 0) *sa = mx > 0.f ? mx * (1.0f / 127.0f) : 1.0f;
}
__device__ __forceinline__ void rms_row_to_q(int lane, const float* xrow, const float* g, signed char* qrow, float* sa) {
    const GAS f32x4* xr = (const GAS f32x4*)xrow + lane; const GAS f32x4* gr = (const GAS f32x4*)g + lane;
    f32x4 v[16]; float s = 0.f;
#pragma unroll
    for (int j = 0; j < 16; ++j) v[j] = __builtin_nontemporal_load(&xr[64 * j]);
    __builtin_amdgcn_sched_barrier(0);
#pragma unroll
    for (int j = 0; j < 16; ++j) s += (v[j].x * v[j].x + v[j].y * v[j].y) + (v[j].z * v[j].z + v[j].w * v[j].w);
    const float r = 1.0f / sqrtf(wave_sum(s) * (1.f / D) + EPS);
#pragma unroll
    for (int j = 0; j < 16; ++j) v[j] = v[j] * r * gr[64 * j];
    quant_row_store(lane, v, qrow, sa);
}

template <int MODE, bool BASE_X, int DIR>
__device__ __forceinline__ void norm_phase(Frame& F, const float* baseP, const float* baseS, const bf16* Y, const float* stats, float c, const float* gpost, const float* g2, float* OUT, bf16* A, signed char* AQ, float* SA) {
    LAS f32x4* gl = (LAS f32x4*)(F.lds + RING_OFF);
    for (int i = F.tid; i < D / 4; i += NWAVES * 64) { gl[i] = ((const GAS f32x4*)gpost)[i]; gl[1024 + i] = ((const GAS f32x4*)g2)[i]; }
    LDS_WAIT(); __syncthreads();
    const int lane = F.lane, nx = (F.G % 8 == 0) ? 8 : 1, gpx = F.G / nx, MX = M / nx, wpx = gpx * NWAVES, xq = F.vcu / gpx, j0 = (F.vcu % gpx) * NWAVES + F.wave;
    for (int j = j0; j < MX; j += wpx) {
        const int m = xq * MX + (DIR ? MX - 1 - j : j);
        const GAS f32x4* br = (const GAS f32x4*)x_row(baseP, baseS, m) + lane;
        GAS v2u* hb = (GAS v2u*)((bf16*)(OUT + (size_t)m * D) + D) + lane;
        const GAS v2u* yr = (const GAS v2u*)(Y + (size_t)m * D) + lane;
        const float ssy = wave_sum(stats[(size_t)m * 64 + lane]);
        const float ry = c / sqrtf(ssy * (1.f / D) + EPS);
        constexpr int NB = (PROBE != 0) ? 8 : 16;
        f32x4 h[16]; v2u yv[NB], bv[BASE_X ? 1 : NB]; float s = 0.f;
#pragma unroll
        for (int jb = 0; jb < 16; jb += NB) {
#pragma unroll
            for (int j = 0; j < NB; ++j) { if constexpr (BASE_X) h[jb + j] = br[64 * (jb + j)]; else bv[j] = hb[64 * (jb + j)];
                yv[j] = yr[64 * (jb + j)]; }
            __builtin_amdgcn_sched_barrier(0);
#pragma unroll
            for (int j = 0; j < NB; ++j) { f32x4 b; if constexpr (BASE_X) b = h[jb + j]; else { const v2u bb = bv[j]; b.x = bf_lo(bb.x); b.y = bf_hi(bb.x); b.z = bf_lo(bb.y); b.w = bf_hi(bb.y); }
                const v2u yy = yv[j]; const f32x4 gp = gl[64 * (jb + j) + lane];
                f32x4 y; y.x = bf_lo(yy.x); y.y = bf_hi(yy.x); y.z = bf_lo(yy.y); y.w = bf_hi(yy.y);
                h[jb + j] = b + y * ry * gp; s += (h[jb + j].x * h[jb + j].x + h[jb + j].y * h[jb + j].y) + (h[jb + j].z * h[jb + j].z + h[jb + j].w * h[jb + j].w); }
            if (NB < 16) __builtin_amdgcn_sched_barrier(0);
        }
        const float rh = 1.0f / sqrtf(wave_sum(s) * (1.f / D) + EPS);
        if constexpr (MODE == 1) {
            GAS f32x4* ho = (GAS f32x4*)(OUT + (size_t)m * D) + lane;
#pragma unroll
            for (int j = 0; j < 16; ++j) { const f32x4 gg = gl[1024 + 64 * j + lane]; ho[64 * j] = h[j] * rh * gg; }
        } else if constexpr (MODE == 0) {
#pragma unroll
            for (int j = 0; j < 16; ++j) { v2u hw; hw.x = pk2(h[j].x, h[j].y); hw.y = pk2(h[j].z, h[j].w); hb[64 * j] = hw; }
            if (lane == 0) SA[m] = rh;
        } else {
#pragma unroll
            for (int j = 0; j < 16; ++j) { const f32x4 gg = gl[1024 + 64 * j + lane]; v2u hw; hw.x = pk2(h[j].x, h[j].y); hw.y = pk2(h[j].z, h[j].w); hb[64 * j] = hw; h[j] = h[j] * rh * gg; }
            quant_row_store(lane, h, AQ + (size_t)m * D, SA + m);
        }
    }
}

__device__ __forceinline__ void spatial_units(Frame& F, int u0, int u1, const bf16* Z, const bf16* WSP, const float* b_sp, const float* v_norm, bf16* YCAT) {
    constexpr int VS = 136, VBUF = 128 * VS * 2;
    const int tid = F.tid, s = tid >> 2, q = tid & 3, w = F.wave, fr = F.lane & 15, fq = F.lane >> 4, t = 16 * w + fr;
    if (u0 >= u1) return;
    v4u vw[4];
    { const GAS v4u* src = (const GAS v4u*)(Z + (size_t)((u0 / NH) * CH + s) * DIN + DA + (u0 % NH) * HD + q * 32);
#pragma unroll
      for (int i = 0; i < 4; ++i) vw[i] = src[i]; }
    for (int ui = u0; ui < u1; ++ui) {
        const int cidx = ui / NH, h = ui % NH, r0 = cidx * CH;
        LAS bf16* vT = (LAS bf16*)(F.lds + RING_OFF + ((ui - u0) & 1) * VBUF);
        bf16x8 af[4];
#pragma unroll
        for (int kk = 0; kk < 4; ++kk) af[kk] = *(const GAS bf16x8*)(WSP + (size_t)h * CH * CH + t * CH + kk * 32 + fq * 8);
        const GAS v4u* ur = (const GAS v4u*)(Z + (size_t)(r0 + t) * DIN + h * HD + 8 * fq);
        v4u uu[4];
#pragma unroll
        for (int p = 0; p < 4; ++p) uu[p] = ur[4 * p];
        const float bias = b_sp[h * CH + t];
        {   float v[32]; float ss = 0.f;
#pragma unroll
            for (int i = 0; i < 4; ++i) { v[8 * i + 0] = bf_lo(vw[i].x); v[8 * i + 1] = bf_hi(vw[i].x); v[8 * i + 2] = bf_lo(vw[i].y); v[8 * i + 3] = bf_hi(vw[i].y);
                v[8 * i + 4] = bf_lo(vw[i].z); v[8 * i + 5] = bf_hi(vw[i].z); v[8 * i + 6] = bf_lo(vw[i].w); v[8 * i + 7] = bf_hi(vw[i].w); }
#pragma unroll
            for (int j = 0; j < 32; ++j) ss += v[j] * v[j];
            ss += __shfl_xor(ss, 1); ss += __shfl_xor(ss, 2);
            const float r = 1.0f / sqrtf(ss * (1.f / HD) + EPS);
            const GAS f32x4* vn = (const GAS f32x4*)(v_norm + h * HD + q * 32);
#pragma unroll
            for (int j4 = 0; j4 < 8; ++j4) { const f32x4 gn = vn[j4];
                vT[(q * 32 + 4 * j4 + 0) * VS + s] = (bf16)f2bf(v[4 * j4 + 0] * r * gn.x); vT[(q * 32 + 4 * j4 + 1) * VS + s] = (bf16)f2bf(v[4 * j4 + 1] * r * gn.y);
                vT[(q * 32 + 4 * j4 + 2) * VS + s] = (bf16)f2bf(v[4 * j4 + 2] * r * gn.z); vT[(q * 32 + 4 * j4 + 3) * VS + s] = (bf16)f2bf(v[4 * j4 + 3] * r * gn.w); }
        }
        LDS_WAIT(); __syncthreads();
        if (ui + 1 < u1) { const int un = ui + 1; const GAS v4u* src = (const GAS v4u*)(Z + (size_t)((un / NH) * CH + s) * DIN + DA + (un % NH) * HD + q * 32);
#pragma unroll
            for (int i = 0; i < 4; ++i) vw[i] = src[i]; }
        f32x4 acc[8];
#pragma unroll
        for (int n = 0; n < 8; ++n) { acc[n] = (f32x4){0.f, 0.f, 0.f, 0.f};
#pragma unroll
            for (int kk = 0; kk < 4; ++kk) { const bf16x8 bfr = *(const LAS bf16x8*)(vT + (32 * (n >> 1) + 8 * (fr >> 2) + 4 * (n & 1) + (fr & 3)) * VS + kk * 32 + fq * 8);
                acc[n] = __builtin_amdgcn_mfma_f32_16x16x32_bf16(bfr, af[kk], acc[n], 0, 0, 0); } }
        GAS v4u* orow = (GAS v4u*)(YCAT + (size_t)(r0 + t) * D + h * HD + 8 * fq);
#pragma unroll
        for (int p = 0; p < 4; ++p) { const v4u w = uu[p]; const f32x4 a0 = acc[2 * p], a1 = acc[2 * p + 1];
            v4u o; o.x = pk2(bf_lo(w.x) * (a0[0] + bias), bf_hi(w.x) * (a0[1] + bias)); o.y = pk2(bf_lo(w.y) * (a0[2] + bias), bf_hi(w.y) * (a0[3] + bias));
            o.z = pk2(bf_lo(w.z) * (a1[0] + bias), bf_hi(w.z) * (a1[1] + bias)); o.w = pk2(bf_lo(w.w) * (a1[2] + bias), bf_hi(w.w) * (a1[3] + bias));
            orow[4 * p] = o; }
    }
    LDS_WAIT(); __syncthreads();
}

__device__ __forceinline__ void acc8(float (&S)[8], const v4u w, float sgn) {
    S[0] += sgn * bf_lo(w.x); S[1] += sgn * bf_hi(w.x); S[2] += sgn * bf_lo(w.y); S[3] += sgn * bf_hi(w.y); S[4] += sgn * bf_lo(w.z); S[5] += sgn * bf_hi(w.z); S[6] += sgn * bf_lo(w.w); S[7] += sgn * bf_hi(w.w); }
template <int HW>
__device__ __forceinline__ void pool_strip8(const bf16* Z, bf16* PB, int strip, int cg) {
    const int m0 = strip * 8;
    const int s0 = (m0 < M_PROMPT) ? (m0 & ~(SEQ_P - 1)) : (M_PROMPT + ((m0 - M_PROMPT) & ~(SEQ_S - 1)));
    const int len = (m0 < M_PROMPT) ? SEQ_P : SEQ_S, t0 = m0 - s0;
    const bf16* zc = Z + (size_t)s0 * DIN + 2 * DA + 8 * cg;
    constexpr int NR = 2 * HW + 7;
    v4u r[NR];
#pragma unroll
    for (int j = 0; j < NR; ++j) { const int t = t0 - HW + j; r[j] = (v4u){0u, 0u, 0u, 0u}; if (t >= 0 && t < len) r[j] = *(const GAS v4u*)(zc + (size_t)t * DIN); }
    float S[8];
#pragma unroll
    for (int i = 0; i < 8; ++i) S[i] = 0.f;
#pragma unroll
    for (int j = 0; j < 2 * HW; ++j) acc8(S, r[j], 1.0f);
#pragma unroll
    for (int i = 0; i < 8; ++i) { const int t = t0 + i;
        const int lo = (t - HW) > 0 ? (t - HW) : 0, hi = (t + HW) < len ? (t + HW) : len;
        const float inv = 1.0f / (float)(hi - lo); const v4u w = r[i + HW];
        v4u o; o.x = pk2(S[0] * inv - bf_lo(w.x), S[1] * inv - bf_hi(w.x)); o.y = pk2(S[2] * inv - bf_lo(w.y), S[3] * inv - bf_hi(w.y));
        o.z = pk2(S[4] * inv - bf_lo(w.z), S[5] * inv - bf_hi(w.z)); o.w = pk2(S[6] * inv - bf_lo(w.w), S[7] * inv - bf_hi(w.w));
        *(GAS v4u*)(PB + (size_t)(s0 + t) * DB + 8 * cg) = o;
        if (i < 7) { acc8(S, r[i + 2 * HW], 1.0f); acc8(S, r[i], -1.0f); } }
}

struct Args { const float* in[22]; float* out; unsigned char* ws; int ph_lo, ph_hi; };
__global__ void __launch_bounds__(NWAVES * 64, 2) mk_fwd(Args args) {
    extern __shared__ __attribute__((aligned(16))) unsigned char lds[];
    Frame F;
    F.lds = (LAS unsigned char*)lds;
    F.MISC = (volatile LAS unsigned*)(F.lds + MISC_OFF);
    F.tid = threadIdx.x; F.lane = F.tid & 63; F.wave = __builtin_amdgcn_readfirstlane(F.tid >> 6);
    F.G = gridDim.x; { const int bx = blockIdx.x; F.vcu = (F.G % 8 == 0) ? (bx % 8) * (F.G / 8) + bx / 8 : bx; }
    unsigned char* ws = args.ws;
    F.ctl = (gu32*)(ws + WS_CTL);
    for (int u = F.tid; u < (LDS_BYTES - LDSCTL_OFF) / 4; u += NWAVES * 64) ((LAS unsigned*)(F.lds + LDSCTL_OFF))[u] = 0u;
    __syncthreads();
    XcdBarrier bar; bar.bar = (unsigned*)(F.ctl + CW_BAR); bar.x = 0; bar.st = nullptr;
    if (N_LAUNCHES == 1) bar = xcd_barrier_post((unsigned*)(F.ctl + CW_BAR), F.MISC + 8);
    volatile LAS unsigned long long* pr = (volatile LAS unsigned long long*)(F.lds + LDSX_OFF + 3072);
    if (PROBE != 0 && F.tid == 0) { pr[0] = 0ull; pr[1] = 0ull; pr[2] = __builtin_amdgcn_s_memrealtime(); }
#define PR_SET() do { if (F.tid == 0) pr[0] = __builtin_amdgcn_s_memrealtime(); } while (0)
#define PR_DIFF() do { if (F.tid == 0) pr[0] = __builtin_amdgcn_s_memrealtime() - pr[0]; } while (0)
    int pr_seam = 0;
#define GRID_BAR() do { if (N_LAUNCHES == 1) { const bool _m = (PROBE == 6) || (PROBE == 12 && pr_seam == PROBE_PH); if (_m && F.tid == 0) pr[3] = __builtin_amdgcn_s_memrealtime(); xcd_barrier(bar); if (_m && F.tid == 0) pr[1] += __builtin_amdgcn_s_memrealtime() - pr[3]; ++pr_seam; } } while (0)
    static_assert(!TEAM_SEAMS || ((((M / 256) * (D / 256)) % 8 == 0) && ((((M / 256) * (D / 256)) / 8) % (WGM_DOWN * (D / 256)) == 0) && ((((M / 256) * (D / 256)) / 8) % (4 * (D / 256)) == 0) && ((M / 8) % 256 == 0)), "team barriers need XCD-aligned panel ownership");
    unsigned tb_seq = 0u;
#define TEAM_BAR() do { if (N_LAUNCHES == 1) { if (!TEAM_SEAMS || (F.G % 8) != 0) { GRID_BAR(); } else { \
        VM_WAIT(); __syncthreads(); \
        if (F.tid == 0) { unsigned* _c = (unsigned*)(F.ctl + CW_TEAM + 64 * ((int)blockIdx.x % 8)); const unsigned _tg = (tb_seq + 1u) * (unsigned)(F.G / 8); \
            __builtin_amdgcn_fence(__ATOMIC_RELEASE, "agent"); VM_WAIT(); (void)xb_add(_c, 1u); \
            XB_SPIN(xb_ld(_c) < _tg, bar.bar); \
            __builtin_amdgcn_fence(__ATOMIC_ACQUIRE, "agent"); VM_WAIT(); } \
        __syncthreads(); ++tb_seq; ++pr_seam; } } } while (0)

    const float* x_p = args.in[0]; const float* x_s = args.in[1];
    signed char* WGU1 = (signed char*)(ws + WS_WGU1); bf16* WD1 = (bf16*)(ws + WS_WD1); signed char* WGU2 = (signed char*)(ws + WS_WGU2); bf16* WD2 = (bf16*)(ws + WS_WD2);
    bf16* WIN = (bf16*)(ws + WS_WIN); bf16* WOUT = (bf16*)(ws + WS_WOUT); bf16* WSP = (bf16*)(ws + WS_WSP); bf16* WPT = (bf16*)(ws + WS_WPT);
    bf16* AB = (bf16*)(ws + WS_A); signed char* AQ = (signed char*)(ws + WS_A); bf16* PB = (bf16*)(ws + WS_A);
    bf16* HID = (bf16*)(ws + WS_HID); bf16* ZB = (bf16*)(ws + WS_Z); bf16* YCAT = (bf16*)(ws + WS_YCAT); bf16* YB = (bf16*)(ws + WS_Y);
    float* STATS = (float*)(ws + WS_STATS); float* SA = (float*)(ws + WS_SA); float* SW1 = (float*)(ws + WS_SW1); float* SW2 = (float*)(ws + WS_SW2);
    float* H = args.out;

    const int lo = args.ph_lo, hi = args.ph_hi;
#define IN(k) (lo <= (k) && (k) < hi)
#define BOTH(k) (IN(k) && IN((k) == 0 ? 2 : (k) + 1))

    LAS float* const scr = (LAS float*)(F.lds + RING_OFF + F.wave * 16384);
    LAS float* const cmx = (LAS float*)(F.lds + LDSX_OFF);
    volatile LAS unsigned* const tkt = (volatile LAS unsigned*)(F.lds + LDSX_OFF + 2048);
    const int lane = F.lane;
    constexpr int NCBLK = FF / 32;
    auto gu_job = [&](const int mat, const int n0, const int jpar) __attribute__((always_inline)) {
            const float* W = args.in[mat == 0 ? 4 : mat == 1 ? 5 : mat == 2 ? 18 : 19];
            const int c4 = lane & 7, krow0 = F.wave * 512 + (lane >> 3) * 64;
            const GAS f32x4* p = (const GAS f32x4*)(W + (size_t)krow0 * FF + n0) + c4;
            v2u d[64]; float m0 = 0.f, m1 = 0.f, m2 = 0.f, m3 = 0.f;
#pragma unroll
            for (int ib = 0; ib < 4; ++ib) {
                f32x4 v[16];
#pragma unroll
                for (int i = 0; i < 16; ++i) v[i] = __builtin_nontemporal_load(&p[(size_t)(16 * ib + i) * (FF / 4)]);
                __builtin_amdgcn_sched_barrier(0);
#pragma unroll
                for (int i = 0; i < 16; ++i) { m0 = fmaxf(m0, fabsf(v[i].x)); m1 = fmaxf(m1, fabsf(v[i].y)); m2 = fmaxf(m2, fabsf(v[i].z)); m3 = fmaxf(m3, fabsf(v[i].w));
                    d[16 * ib + i].x = pg8::cvt_pk_bf16(v[i].x, v[i].y); d[16 * ib + i].y = pg8::cvt_pk_bf16(v[i].z, v[i].w); }
                __builtin_amdgcn_sched_barrier(0);
            }
#pragma unroll
            for (int o = 8; o < 64; o <<= 1) { m0 = fmaxf(m0, __shfl_xor(m0, o)); m1 = fmaxf(m1, __shfl_xor(m1, o)); m2 = fmaxf(m2, __shfl_xor(m2, o)); m3 = fmaxf(m3, __shfl_xor(m3, o)); }
            if (lane < 8) { LAS float* cw = cmx + (jpar * 8 + F.wave) * 32 + 4 * lane; cw[0] = m0; cw[1] = m1; cw[2] = m2; cw[3] = m3; }
            LDS_WAIT(); __syncthreads();
            f32x4 cm4 = (f32x4){0.f, 0.f, 0.f, 0.f};
#pragma unroll
            for (int w8 = 0; w8 < 8; ++w8) { const f32x4 cv = *(const LAS f32x4*)(cmx + (jpar * 8 + w8) * 32 + 4 * c4); cm4.x = fmaxf(cm4.x, cv.x); cm4.y = fmaxf(cm4.y, cv.y); cm4.z = fmaxf(cm4.z, cv.z); cm4.w = fmaxf(cm4.w, cv.w); }
            const float i0 = cm4.x > 0.f ? 127.0f / cm4.x : 0.f, i1 = cm4.y > 0.f ? 127.0f / cm4.y : 0.f, i2 = cm4.z > 0.f ? 127.0f / cm4.z : 0.f, i3 = cm4.w > 0.f ? 127.0f / cm4.w : 0.f;
            const int drow0 = 256 * (n0 >> 7) + (n0 & 127) + ((mat & 1) ? 128 : 0);
            signed char* WQ = mat < 2 ? WGU1 : WGU2;
            GAS char* q0p = (GAS char*)WQ + (size_t)(drow0 >> 8) * WGU_PS + (size_t)((drow0 & 255) + 4 * c4) * D + krow0;
#pragma unroll
            for (int b = 0; b < 4; ++b) {
                v4u o0, o1, o2, o3;
#pragma unroll
                for (int a = 0; a < 4; ++a) { const v2u r0 = d[16 * b + 4 * a + 0], r1 = d[16 * b + 4 * a + 1], r2 = d[16 * b + 4 * a + 2], r3 = d[16 * b + 4 * a + 3];
                    o0[a] = pk4q(bf_lo(r0.x) * i0, bf_lo(r1.x) * i0, bf_lo(r2.x) * i0, bf_lo(r3.x) * i0); o1[a] = pk4q(bf_hi(r0.x) * i1, bf_hi(r1.x) * i1, bf_hi(r2.x) * i1, bf_hi(r3.x) * i1);
                    o2[a] = pk4q(bf_lo(r0.y) * i2, bf_lo(r1.y) * i2, bf_lo(r2.y) * i2, bf_lo(r3.y) * i2); o3[a] = pk4q(bf_hi(r0.y) * i3, bf_hi(r1.y) * i3, bf_hi(r2.y) * i3, bf_hi(r3.y) * i3); }
                *(GAS v4u*)(q0p + 0 * D + 16 * b) = o0; *(GAS v4u*)(q0p + 1 * D + 16 * b) = o1; *(GAS v4u*)(q0p + 2 * D + 16 * b) = o2; *(GAS v4u*)(q0p + 3 * D + 16 * b) = o3; }
            if (F.wave == 0 && lane < 8) { float* swp = (mat < 2 ? SW1 : SW2) + drow0 + 4 * c4;
                swp[0] = cm4.x > 0.f ? cm4.x * (1.0f / 127.0f) : 1.0f; swp[1] = cm4.y > 0.f ? cm4.y * (1.0f / 127.0f) : 1.0f; swp[2] = cm4.z > 0.f ? cm4.z * (1.0f / 127.0f) : 1.0f; swp[3] = cm4.w > 0.f ? cm4.w * (1.0f / 127.0f) : 1.0f; }
    };
    constexpr int I_D = (FF / 64) * (D / 32), I_IN = (D / 64) * (DIN / 32), I_OUT = (D / 64) * (D / 32), I_P = (DPG / 64) * (DPG / 32);
    constexpr int NITEMS = 2 * I_D + I_IN + I_OUT + 4 * I_P, NCT = NITEMS / 32, NCX = M / 32;
    constexpr int NC_D2 = I_D / 32;
    static_assert(I_D % 32 == 0 && !(WD2_IN_P10 && BG_TR), "WD2 chunks");
    static_assert(NITEMS % 32 == 0 && M % 32 == 0 && I_D % 4 == 0 && I_IN % 4 == 0 && I_OUT % 4 == 0 && I_P % 4 == 0, "queue chunks");
    auto tr_chunk = [&](const int cur) __attribute__((always_inline)) {
        int r = (cur * 8 + F.wave) * 4;
        TJob J;
        if (r < I_D) J = TJob{args.in[6], WD1, FF, D, 0, 1, nullptr};
        else if ((r -= I_D) < I_IN) J = TJob{args.in[9], WIN, D, DIN, 0, 0, args.in[7]};
        else if ((r -= I_IN) < I_OUT) J = TJob{args.in[15], WOUT, D, D, 0, 0, nullptr};
        else if ((r -= I_OUT) < 4 * I_P) { const int gp = r / I_P; J = TJob{args.in[13] + (size_t)gp * DPG * DPG, WPT, DPG, DPG, gp * DPG, 0, nullptr}; r -= gp * I_P; }
        else { r -= 4 * I_P; J = TJob{args.in[20], WD2, FF, D, 0, 1, nullptr}; }
#pragma unroll
        for (int i = 0; i < 4; i += 2) { f32x4 va[8], vb[8];
            tr_load(J, r + i, lane, va); tr_load(J, r + i + 1, lane, vb);
            __builtin_amdgcn_sched_barrier(0);
            tr_commit(J, r + i, lane, va, scr); tr_commit(J, r + i + 1, lane, vb, scr); }
    };
    if (IN(0)) { if (PROBE == 11 && PROBE_PH == 0) PR_SET();
        constexpr int NJOBS = (BG_IN_P2 ? 2 : 4) * NCBLK;
        int jpar = 0;
        for (int job = F.vcu; job < NJOBS; job += F.G, jpar ^= 1) gu_job(job / NCBLK, (job % NCBLK) * 32, jpar);
        for (int i = (blockIdx.x * NWAVES * 64 + F.tid); i < NH * CH * CH / 4; i += F.G * NWAVES * 64) {
            const f32x4 v = ((const GAS f32x4*)args.in[10])[i]; v2u w; w.x = pk2(v.x, v.y); w.y = pk2(v.z, v.w); ((GAS v2u*)WSP)[i] = w; }
        constexpr int NT0 = (BG_IN_P2 && BG_TR) ? 0 : NCT - (WD2_IN_P10 ? NC_D2 : 0), NCHUNK = NT0 + NCX;
        unsigned* qhead = (unsigned*)(F.ctl + CW_QUEUE);
        unsigned nxt = 0u; int tpar = 0;
        if (F.tid == 0) nxt = __hip_atomic_fetch_add(qhead, 1u, RLX_AGENT);
        for (;;) {
            if (F.tid == 0) tkt[tpar] = nxt;
            LDS_WAIT(); __syncthreads();
            const unsigned cur = tkt[tpar]; tpar ^= 1;
            if (cur >= (unsigned)NCHUNK) break;
            if (F.tid == 0) nxt = __hip_atomic_fetch_add(qhead, 1u, RLX_AGENT);
            if (cur < (unsigned)NT0) tr_chunk((int)cur);
            else { for (int i = 0; i < 4; ++i) { const int m = (((int)cur - NT0) * 8 + F.wave) * 4 + i; rms_row_to_q(lane, x_row(x_p, x_s, m), args.in[2], AQ + (size_t)m * D, SA + m); } }
        }
        if (BOTH(0)) GRID_BAR();
        if (PROBE == 11 && PROBE_PH == 0) PR_DIFF();
        if (PROBE == 9) do { if (F.tid == 0) pr[0] = __builtin_amdgcn_s_memrealtime() - pr[2]; } while (0);
    }
    if (IN(2)) { if (PROBE == 11 && PROBE_PH == 2) PR_SET();
        const int GG = BG_IN_P2 ? F.G - NBG : F.G;
        if ((int)blockIdx.x < GG) {
            pg8::Gemm g = pg8::gemm_rm(AQ, WGU1, D, D, D); g.tstepB = WGU_PS; pg8::StaticOrder S; S.init(M, NGU, GG, (int)blockIdx.x, WGM_GU);
            pg8::EpiSwiGLUQ E{HID, HID_PT * 64, SA, SW1};
            pg8::gemm_phase<pg8::EpiSwiGLUQ, pg8::StaticOrder, true>(F.lds + RING_OFF, g, S, E);
        }
        if (BG_IN_P2) {
            constexpr int NJ2 = 2 * NCBLK, NTK = NJ2 + (BG_TR ? NCT : 0);
            unsigned* qhead = (unsigned*)(F.ctl + CW_QUEUE2);
            unsigned nxt = 0u; int tpar = 0, jpar = 0;
            if (F.tid == 0) nxt = __hip_atomic_fetch_add(qhead, 1u, RLX_AGENT);
            for (;;) {
                if (F.tid == 0) tkt[tpar] = nxt;
                LDS_WAIT(); __syncthreads();
                const unsigned cur = tkt[tpar]; tpar ^= 1;
                if (cur >= (unsigned)NTK) break;
                if (F.tid == 0) nxt = __hip_atomic_fetch_add(qhead, 1u, RLX_AGENT);
                if (cur < (unsigned)NJ2) { gu_job(2 + (int)cur / NCBLK, ((int)cur % NCBLK) * 32, jpar); jpar ^= 1; }
                else tr_chunk((int)cur - NJ2);
            }
        }
        if (BOTH(2)) GRID_BAR();
        if (PROBE == 11 && PROBE_PH == 2) PR_DIFF();
    }
    if (IN(3)) { if (PROBE == 11 && PROBE_PH == 3) PR_SET();
        pg8::Gemm g = pg8::gemm_tiled(HID, WD1, FF * 2, HID_PT); pg8::StaticOrder S; S.init(M, D, F.G, (int)blockIdx.x, WGM_DOWN, REV_DOWN);
        pg8::EpiYStats E{YB, D, STATS};
        pg8::gemm_phase<pg8::EpiYStats, pg8::StaticOrder, true>(F.lds + RING_OFF, g, S, E);
        if (BOTH(3)) TEAM_BAR();
        if (PROBE == 11 && PROBE_PH == 3) PR_DIFF();
    }
    if (IN(4)) { if (PROBE == 11 && PROBE_PH == 4) PR_SET();
        norm_phase<0, true, 0>(F, x_p, x_s, YB, STATS, 0.5f, args.in[3], args.in[7], H, nullptr, nullptr, SA);
        if (BOTH(4)) GRID_BAR();
        if (PROBE == 11 && PROBE_PH == 4) PR_DIFF();
    }
    if (IN(5)) { if (PROBE == 11 && PROBE_PH == 5) PR_SET();
        pg8::Gemm g = pg8::gemm_rm((const char*)H + D * 2, WIN, D * 4, D * 2, D * 2);   pg8::MixOrder S; S.init(M, DIN, F.G, (int)blockIdx.x, 4, 1);
        pg8::EpiZ E{ZB, DIN, (2 * DA) / 256, SA};
        pg8::gemm_phase<pg8::EpiZ, pg8::MixOrder, true>(F.lds + RING_OFF, g, S, E);
        if (BOTH(5)) GRID_BAR();
        if (PROBE == 11 && PROBE_PH == 5) PR_DIFF();
    }
    if (IN(6)) { if (PROBE == 11 && PROBE_PH == 6) PR_SET();
        constexpr int NUNITS = (M / CH) * NH;
        const int per = (NUNITS + F.G - 1) / F.G;
        { const int ua = F.vcu * per, ub = (ua + per) < NUNITS ? (ua + per) : NUNITS; spatial_units(F, ua, ub, ZB, WSP, args.in[11], args.in[12], YCAT); }
        constexpr int NSTRIPS = M / 8;
        for (int sp = F.vcu * 2 + (F.tid >> 8); sp < NSTRIPS; sp += F.G * 2) { const int cg = F.tid & 255;
            switch (cg >> 6) { case 0: pool_strip8<1>(ZB, PB, sp, cg); break; case 1: pool_strip8<2>(ZB, PB, sp, cg); break; case 2: pool_strip8<4>(ZB, PB, sp, cg); break; default: pool_strip8<8>(ZB, PB, sp, cg); break; } }
        if (BOTH(6)) GRID_BAR();
        if (PROBE == 11 && PROBE_PH == 6) PR_DIFF();
    }
    if (IN(7)) { if (PROBE == 11 && PROBE_PH == 7) PR_SET();
        pg8::Gemm g = pg8::gemm_rm(PB, WPT, DB * 2, DPG * 2, DPG * 2, DPG * 2); pg8::StaticOrder S; S.init(M, DB, F.G, (int)blockIdx.x);
        pg8::EpiScale E{YCAT, D, DA, args.in[14]};
        pg8::gemm_phase<pg8::EpiScale, pg8::StaticOrder, true>(F.lds + RING_OFF, g, S, E);
        if (BOTH(7)) GRID_BAR();
        if (PROBE == 11 && PROBE_PH == 7) PR_DIFF();
    }
    if (IN(8)) { if (PROBE == 11 && PROBE_PH == 8) PR_SET();
        pg8::Gemm g = pg8::gemm_rm(YCAT, WOUT, D * 2, D * 2, D * 2); pg8::StaticOrder S; S.init(M, D, F.G, (int)blockIdx.x, 4);
        pg8::EpiYStats E{YB, D, STATS};
        pg8::gemm_phase<pg8::EpiYStats, pg8::StaticOrder, true>(F.lds + RING_OFF, g, S, E);
        if (BOTH(8)) TEAM_BAR();
        if (PROBE == 11 && PROBE_PH == 8) PR_DIFF();
    }
    if (IN(9)) { if (PROBE == 11 && PROBE_PH == 9) PR_SET();
        norm_phase<2, false, 1>(F, nullptr, nullptr, YB, STATS, 1.0f, args.in[8], args.in[16], H, nullptr, AQ, SA);
        if (BOTH(9)) GRID_BAR();
        if (PROBE == 11 && PROBE_PH == 9) PR_DIFF();
    }
    if (IN(10)) { if (PROBE == 11 && PROBE_PH == 10) PR_SET();
        pg8::Gemm g = pg8::gemm_rm(AQ, WGU2, D, D, D); g.tstepB = WGU_PS; pg8::StaticOrder S; S.init(M, NGU, F.G, (int)blockIdx.x, WGM_GU);
        pg8::EpiSwiGLUQ E{HID, HID_PT * 64, SA, SW2};
        pg8::gemm_phase<pg8::EpiSwiGLUQ, pg8::StaticOrder, true>(F.lds + RING_OFF, g, S, E);
        if (WD2_IN_P10) {
            unsigned* qhead = (unsigned*)(F.ctl + CW_QUEUE3);
            unsigned nxt = 0u; int tpar = 0;
            if (F.tid == 0) nxt = __hip_atomic_fetch_add(qhead, 1u, RLX_AGENT);
            for (;;) {
                if (F.tid == 0) tkt[tpar] = nxt;
                LDS_WAIT(); __syncthreads();
                const unsigned cur = tkt[tpar]; tpar ^= 1;
                if (cur >= (unsigned)NC_D2) break;
                if (F.tid == 0) nxt = __hip_atomic_fetch_add(qhead, 1u, RLX_AGENT);
                tr_chunk(NCT - NC_D2 + (int)cur);
            }
        }
        if (BOTH(10)) GRID_BAR();
        if (PROBE == 11 && PROBE_PH == 10) PR_DIFF();
    }
    if (IN(11)) { if (PROBE == 11 && PROBE_PH == 11) PR_SET();
        pg8::Gemm g = pg8::gemm_tiled(HID, WD2, FF * 2, HID_PT); pg8::StaticOrder S; S.init(M, D, F.G, (int)blockIdx.x, WGM_DOWN, REV_DOWN);
        pg8::EpiYStats E{YB, D, STATS};
        pg8::gemm_phase<pg8::EpiYStats, pg8::StaticOrder, true>(F.lds + RING_OFF, g, S, E);
        if (BOTH(11)) TEAM_BAR();
        if (PROBE == 11 && PROBE_PH == 11) PR_DIFF();
    }
    if (IN(12)) { if (PROBE == 11 && PROBE_PH == 12) PR_SET();
        norm_phase<1, false, 0>(F, nullptr, nullptr, YB, STATS, 0.5f, args.in[17], args.in[21], H, nullptr, nullptr, nullptr);
    }
    if (PROBE == 9 || PROBE == 10 || PROBE == 11) {
        GRID_BAR();
        if (blockIdx.x == 0 && F.tid == 0) { const unsigned long long t0 = __builtin_amdgcn_s_memrealtime(); const unsigned long long pm = pr[0]; const unsigned long long lim = pm < 500000ull ? pm : 500000ull; while (__builtin_amdgcn_s_memrealtime() - t0 < lim) __builtin_amdgcn_s_sleep(8); }
    }
    if (PROBE == 6 || PROBE == 12) {
        if (F.tid == 0) atomicAdd((unsigned long long*)(F.ctl + CW_PROBE), (unsigned long long)pr[1]);
        GRID_BAR();
        if (blockIdx.x == 0 && F.tid == 0) { const unsigned long long tot = __hip_atomic_load((unsigned long long*)(F.ctl + CW_PROBE), RLX_AGENT) / (unsigned long long)F.G;
            const unsigned long long t0 = __builtin_amdgcn_s_memrealtime(); const unsigned long long lim = tot < 500000ull ? tot : 500000ull; while (__builtin_amdgcn_s_memrealtime() - t0 < lim) __builtin_amdgcn_s_sleep(8); }
    }
#undef IN
#undef BOTH
#undef GRID_BAR
}

extern "C" void kernel_launch(void* const* d_in, const int* in_sizes, int n_in, void* d_out, int out_size, void* d_ws, size_t ws_size, hipStream_t stream) {
    static int grid = 0;
    if (grid == 0) {
        if (n_in != 22 || in_sizes[0] != M_PROMPT * D || out_size != M * D || ws_size < WS_END) {
            fprintf(stderr, "kernel_launch: shape/workspace mismatch: n_in %d in0 %d out %d ws %zu (need %zu); nothing launched\n", n_in, n_in > 0 ? in_sizes[0] : -1, out_size, ws_size, (size_t)WS_END); grid = -1; return; }
        int dev = 0, cus = 0, per_cu = 0;
        if (hipGetDevice(&dev) != hipSuccess || hipDeviceGetAttribute(&cus, hipDeviceAttributeMultiprocessorCount, dev) != hipSuccess) { fprintf(stderr, "kernel_launch: device query failed\n"); grid = -1; return; }
        if (hipFuncSetAttribute((const void*)mk_fwd, hipFuncAttributeMaxDynamicSharedMemorySize, LDS_BYTES) != hipSuccess) { fprintf(stderr, "kernel_launch: hipFuncSetAttribute failed\n"); grid = -1; return; }
        if (hipOccupancyMaxActiveBlocksPerMultiprocessor(&per_cu, (const void*)mk_fwd, NWAVES * 64, LDS_BYTES) != hipSuccess || per_cu < 1) {
            fprintf(stderr, "kernel_launch: occupancy query reports %d workgroups per CU\n", per_cu); }
        (void)hipGetLastError();
        grid = cus;
    }
    if (grid < 0) return;
    if (hipMemsetAsync((char*)d_ws + WS_CTL, 0, CTL_ZERO_BYTES, stream) != hipSuccess) { fprintf(stderr, "kernel_launch: memset failed\n"); return; }
    Args a{};
    for (int i = 0; i < 22; ++i) a.in[i] = (const float*)d_in[i];
    a.out = (float*)d_out; a.ws = (unsigned char*)d_ws;
    if (N_LAUNCHES == 1) { a.ph_lo = 0; a.ph_hi = N_PHASES; hipLaunchKernelGGL(mk_fwd, dim3(grid), dim3(NWAVES * 64), LDS_BYTES, stream, a); }
    else for (int li = 0; li < N_PHASES; ++li) { a.ph_lo = li; a.ph_hi = li + 1; hipLaunchKernelGGL(mk_fwd, dim3(grid), dim3(NWAVES * 64), LDS_BYTES, stream, a); }
    const hipError_t le = hipPeekAtLastError();
    if (le != hipSuccess) fprintf(stderr, "kernel_launch: launch failed: %s\n", hipGetErrorName(le));
}
```
